# Optimizing an MI355X kernel written in HIP

```python
import math
import jax, jax.numpy as jnp
from jax import lax
import numpy as np

D_MODEL = 1024
BATCH = 4
SEQ = 4096
DEPTH = 4

GRID_W = 64
CTX_LEN = 256
N_EVEN = (DEPTH + 1) // 2
N_ODD = DEPTH // 2
N_MOD = 6
NORM_EPS = 1e-6
W_A = D_MODEL // 2
HY_ORDER = 2
HY_SHORT = 3
HY_BANDS = 16
HY_EMB = 2 * HY_BANDS + 1
HY_FFN = 64
HY_TARGET = 1e-2
HY_FAST_PCT = 0.3
HY_SLOW_PCT = 1.5
W_B = D_MODEL // 2
SGU_GROUPS = 4
SGU_DH = W_B // SGU_GROUPS
CHUNK = 128
D_RNN = ((4 * D_MODEL // 3 + 127) // 128) * 128
RG_HEADS = 16
RG_DH = D_RNN // RG_HEADS
RG_CONV = 4
RG_C = 8.0
D_FF = ((8 * D_MODEL // 3 + 255) // 256) * 256

kernel_name = 'hybrid_hyena_sgu_rglru_dit_block'


def rmsnorm(x, g):
    xf = x.astype(jnp.float32)
    xf = xf * lax.rsqrt(jnp.mean(xf * xf, axis=-1, keepdims=True) + NORM_EPS)
    return xf.astype(x.dtype) * g


def layernorm(x, g):
    xf = x.astype(jnp.float32)
    xc = xf - jnp.mean(xf, axis=-1, keepdims=True)
    xf = xc * lax.rsqrt(jnp.mean(xc * xc, axis=-1, keepdims=True) + NORM_EPS)
    return xf.astype(x.dtype) * g


def modulate(h, shift, scale):
    return h * (1 + scale) + shift


def depthwise_conv(x, w, b, left):
    k_w, L = w.shape[0], x.shape[1]
    xp = jnp.pad(x, ((0, 0), (left, k_w - 1 - left), (0, 0)))
    y = b
    for k in range(k_w):
        y = y + xp[:, k:k + L] * w[k]
    return y


def to_col_major(x):
    b, L, d = x.shape
    rows = L // GRID_W
    return x.reshape(b, rows, GRID_W, d).transpose(0, 2, 1, 3).reshape(b, L, d)


def to_row_major(x):
    b, L, d = x.shape
    rows = L // GRID_W
    return x.reshape(b, GRID_W, rows, d).transpose(0, 2, 1, 3).reshape(b, L, d)


def swiglu(h, w_in, w_out):
    z = h @ w_in
    return (jax.nn.silu(z[..., :D_FF]) * z[..., D_FF:]) @ w_out


def hyena_filter_spectrum(L, f1_w, f1_b, f2_w, f2_b, f3_w, f3_b, sin_freq):
    t = jnp.linspace(0.0, 1.0, L, dtype=jnp.float32)[:, None]
    w = 2.0 * math.pi * jnp.arange(L, dtype=jnp.float32)[:, None] / L
    f = jnp.linspace(1e-4, HY_BANDS - 1, HY_BANDS, dtype=jnp.float32)[None, :]
    emb = jnp.concatenate([t, jnp.cos(f * w), -jnp.sin(f * w)], axis=-1)
    hdn = jnp.sin(sin_freq * (emb @ f1_w + f1_b))
    hdn = jnp.sin(sin_freq * (hdn @ f2_w + f2_b))
    h = (hdn @ f3_w + f3_b).astype(jnp.float32).reshape(L, HY_ORDER, 2, W_A)
    deltas = jnp.abs(jnp.linspace(math.log(HY_TARGET) / HY_SLOW_PCT,
                                  math.log(HY_TARGET) / HY_FAST_PCT, W_A, dtype=jnp.float32))
    h = h * jnp.exp(-t[:, :, None, None] * deltas)
    k = jnp.concatenate([h[:, :, 0], jnp.zeros((1, HY_ORDER, W_A), jnp.float32), h[:0:-1, :, 1]], axis=0)
    k = k * lax.rsqrt(jnp.sum(k * k, axis=0, keepdims=True) + NORM_EPS)
    return jnp.fft.rfft(k, n=2 * L, axis=0)


def long_conv(z, kf):
    L = z.shape[1]
    zf = jnp.fft.rfft(z.astype(jnp.float32), n=2 * L, axis=1)
    return jnp.fft.irfft(zf * kf, n=2 * L, axis=1)[:, :L].astype(z.dtype)


def hyena_sgu_mixer(h, w_in, w_out, hy_conv_w, hy_conv_b, hy_f1_w, hy_f1_b, hy_f2_w, hy_f2_b,
                    hy_f3_w, hy_f3_b, hy_sin_freq, hy_skip, sgu_ln_g, sgu_w, sgu_b):
    b, L, _ = h.shape
    z = h @ w_in
    za = depthwise_conv(z[..., :3 * W_A], hy_conv_w, hy_conv_b, left=1)
    v, g1, g2 = za[..., :W_A], za[..., W_A:2 * W_A], za[..., 2 * W_A:]
    kf = hyena_filter_spectrum(L, hy_f1_w, hy_f1_b, hy_f2_w, hy_f2_b, hy_f3_w, hy_f3_b, hy_sin_freq)
    y = g1 * (long_conv(v, kf[:, 0]) + hy_skip[0] * v)
    y_a = g2 * (long_conv(y, kf[:, 1]) + hy_skip[1] * y)
    zb = jax.nn.gelu(z[..., 3 * W_A:])
    u, vb = zb[..., :W_B], zb[..., W_B:]
    vb = layernorm(vb, sgu_ln_g).reshape(b, L // CHUNK, CHUNK, SGU_GROUPS, SGU_DH)
    s = jnp.einsum('gpq,bnqgd->bnpgd', sgu_w, vb) + sgu_b.T[None, None, :, :, None]
    y_b = u * s.reshape(b, L, W_B)
    return jnp.concatenate([y_a, y_b], axis=-1) @ w_out


def rglru_coeffs(xb, w_a, b_a, w_x, b_x, lam):
    b, L, _ = xb.shape
    xh = xb.reshape(b, L, RG_HEADS, RG_DH)
    r = jax.nn.sigmoid(jnp.einsum('blhd,hde->blhe', xh, w_a).reshape(b, L, D_RNN) + b_a)
    gi = jax.nn.sigmoid(jnp.einsum('blhd,hde->blhe', xh, w_x).reshape(b, L, D_RNN) + b_x)
    log_a = (-RG_C * r.astype(jnp.float32)) * jax.nn.softplus(-lam.astype(jnp.float32))
    a = jnp.exp(log_a)
    bx = jnp.sqrt(-jnp.expm1(2.0 * log_a)) * (gi * xb).astype(jnp.float32)
    return a, bx


def linear_scan(a, bx, h0, reverse):
    if h0 is not None:
        edge = -1 if reverse else 0
        bx = bx.at[:, edge].add(a[:, edge] * h0)

    def combine(e1, e2):
        a1, b1 = e1
        a2, b2 = e2
        return a1 * a2, a2 * b1 + b2

    _, h = lax.associative_scan(combine, (a, bx), reverse=reverse, axis=1)
    return h


def bidir_rglru_mixer(h_lat, h_ctx, col_major, ctx_out, w_in, conv_w, conv_b, wa, ba, wx, bx, lam, w_out):
    xc = depthwise_conv(h_ctx @ w_in[:, D_RNN:], conv_w, conv_b, left=2)
    af, bf = rglru_coeffs(xc, wa[0], ba[0], wx[0], bx[0], lam[0])
    ab, bb = rglru_coeffs(xc, wa[1], ba[1], wx[1], bx[1], lam[1])
    hf_c = linear_scan(af, bf, None, False)
    hb_c = linear_scan(ab, bb, None, True)
    if col_major:
        h_lat = to_col_major(h_lat)
    z = h_lat @ w_in
    gate = jax.nn.gelu(z[..., :D_RNN])
    xl = depthwise_conv(z[..., D_RNN:], conv_w, conv_b, left=2)
    af, bf = rglru_coeffs(xl, wa[0], ba[0], wx[0], bx[0], lam[0])
    ab, bb = rglru_coeffs(xl, wa[1], ba[1], wx[1], bx[1], lam[1])
    hf = linear_scan(af, bf, hf_c[:, -1], False)
    hb = linear_scan(ab, bb, hb_c[:, 0], True)
    y_lat = (gate * (hf + hb).astype(gate.dtype)) @ w_out
    if col_major:
        y_lat = to_row_major(y_lat)
    if ctx_out:
        gate_c = jax.nn.gelu(h_ctx @ w_in[:, :D_RNN])
        y_ctx = (gate_c * (hf_c + hb_c).astype(gate_c.dtype)) @ w_out
        return y_lat, y_ctx
    return y_lat, None


def setup_inputs(seed: int = 0) -> dict:
    key = jax.random.key(seed)
    keys = jax.random.split(key, 40)
    counter = [0]

    def nxt():
        k = keys[counter[0]]
        counter[0] += 1
        return k

    def nrm(shape, scale):
        return jax.random.normal(nxt(), shape, jnp.float32) * scale

    def gain(shape):
        return 1.0 + nrm(shape, 0.05)

    D = D_MODEL
    u = jax.random.uniform(nxt(), (N_ODD, 2, D_RNN), jnp.float32, minval=0.9, maxval=0.999)
    sig = u ** (1.0 / RG_C)
    rg_lam = jnp.log(sig / (1.0 - sig))
    return {
        'x': nrm((BATCH, SEQ, D), 1.0),
        'c': nrm((BATCH, D), 1.0),
        'ctx': nrm((BATCH, CTX_LEN, D), 1.0),
        'c_ctx': nrm((D,), 1.0),
        'w_ada': nrm((DEPTH, D, N_MOD * D), 0.5 * D ** -0.5),
        'b_ada': nrm((DEPTH, N_MOD * D), 0.02),
        'norm_mix_g': gain((DEPTH, D)),
        'norm_ffn_g': gain((DEPTH, D)),
        'w_in_even': nrm((N_EVEN, D, 3 * W_A + 2 * W_B), D ** -0.5),
        'w_out_even': nrm((N_EVEN, W_A + W_B, D), (W_A + W_B) ** -0.5),
        'hy_conv_w': nrm((N_EVEN, HY_SHORT, 3 * W_A), HY_SHORT ** -0.5),
        'hy_conv_b': nrm((N_EVEN, 3 * W_A), 0.02),
        'hy_f1_w': nrm((N_EVEN, HY_EMB, HY_FFN), HY_EMB ** -0.5),
        'hy_f1_b': nrm((N_EVEN, HY_FFN), 0.1),
        'hy_f2_w': nrm((N_EVEN, HY_FFN, HY_FFN), HY_FFN ** -0.5),
        'hy_f2_b': nrm((N_EVEN, HY_FFN), 0.1),
        'hy_f3_w': nrm((N_EVEN, HY_FFN, HY_ORDER * 2 * W_A), HY_FFN ** -0.5),
        'hy_f3_b': nrm((N_EVEN, HY_ORDER * 2 * W_A), 0.02),
        'hy_sin_freq': gain((N_EVEN, HY_FFN)),
        'hy_skip': nrm((N_EVEN, HY_ORDER, W_A), 0.5),
        'sgu_ln_g': gain((N_EVEN, W_B)),
        'sgu_w': nrm((N_EVEN, SGU_GROUPS, CHUNK, CHUNK), CHUNK ** -0.5),
        'sgu_b': 1.0 + nrm((N_EVEN, SGU_GROUPS, CHUNK), 0.1),
        'w_in_odd': nrm((N_ODD, D, 2 * D_RNN), D ** -0.5),
        'rg_conv_w': nrm((N_ODD, RG_CONV, D_RNN), RG_CONV ** -0.5),
        'rg_conv_b': nrm((N_ODD, D_RNN), 0.02),
        'rg_wa': nrm((N_ODD, 2, RG_HEADS, RG_DH, RG_DH), RG_DH ** -0.5),
        'rg_ba': nrm((N_ODD, 2, D_RNN), 0.02),
        'rg_wx': nrm((N_ODD, 2, RG_HEADS, RG_DH, RG_DH), RG_DH ** -0.5),
        'rg_bx': nrm((N_ODD, 2, D_RNN), 0.02),
        'rg_lam': rg_lam,
        'w_out_odd': nrm((N_ODD, D_RNN, D), D_RNN ** -0.5),
        'w_ffn_in': nrm((DEPTH, D, 2 * D_FF), D ** -0.5),
        'w_ffn_out': nrm((DEPTH, D_FF, D), D_FF ** -0.5),
        'final_norm_g': gain((D,)),
    }


def reference(x, c, ctx, c_ctx, w_ada, b_ada, norm_mix_g, norm_ffn_g,
              w_in_even, w_out_even, hy_conv_w, hy_conv_b, hy_f1_w, hy_f1_b, hy_f2_w, hy_f2_b,
              hy_f3_w, hy_f3_b, hy_sin_freq, hy_skip, sgu_ln_g, sgu_w, sgu_b,
              w_in_odd, rg_conv_w, rg_conv_b, rg_wa, rg_ba, rg_wx, rg_bx, rg_lam, w_out_odd,
              w_ffn_in, w_ffn_out, final_norm_g):
    silu_c = jax.nn.silu(c)
    silu_cc = jax.nn.silu(c_ctx)
    for l in range(DEPTH):
        run_ctx = l < DEPTH - 1
        is_rec = l % 2 == 1
        i = l // 2
        mod_x = (silu_c @ w_ada[l] + b_ada[l]).reshape(-1, 1, N_MOD, D_MODEL)
        hx = modulate(rmsnorm(x, norm_mix_g[l]), mod_x[:, :, 0], mod_x[:, :, 1])
        if run_ctx or is_rec:
            mod_c = (silu_cc @ w_ada[l] + b_ada[l]).reshape(1, 1, N_MOD, D_MODEL)
            hc = modulate(rmsnorm(ctx, norm_mix_g[l]), mod_c[:, :, 0], mod_c[:, :, 1])
        if is_rec:
            mix_x, mix_c = bidir_rglru_mixer(hx, hc, i % 2 == 1, run_ctx, w_in_odd[i], rg_conv_w[i],
                                             rg_conv_b[i], rg_wa[i], rg_ba[i], rg_wx[i], rg_bx[i],
                                             rg_lam[i], w_out_odd[i])
        else:
            ep = (w_in_even[i], w_out_even[i], hy_conv_w[i], hy_conv_b[i], hy_f1_w[i], hy_f1_b[i],
                  hy_f2_w[i], hy_f2_b[i], hy_f3_w[i], hy_f3_b[i], hy_sin_freq[i], hy_skip[i],
                  sgu_ln_g[i], sgu_w[i], sgu_b[i])
            mix_x = hyena_sgu_mixer(hx, *ep)
            mix_c = hyena_sgu_mixer(hc, *ep) if run_ctx else None
        x = x + mod_x[:, :, 2] * mix_x
        hx = modulate(rmsnorm(x, norm_ffn_g[l]), mod_x[:, :, 3], mod_x[:, :, 4])
        x = x + mod_x[:, :, 5] * swiglu(hx, w_ffn_in[l], w_ffn_out[l])
        if run_ctx:
            ctx = ctx + mod_c[:, :, 2] * mix_c
            hc = modulate(rmsnorm(ctx, norm_ffn_g[l]), mod_c[:, :, 3], mod_c[:, :, 4])
            ctx = ctx + mod_c[:, :, 5] * swiglu(hc, w_ffn_in[l], w_ffn_out[l])
    return rmsnorm(x, final_norm_g)
```

```cpp
#include <hip/hip_runtime.h>
#include <hip/hip_cooperative_groups.h>
#include <cstdio>
#include <cstdint>
namespace cg = cooperative_groups;
#ifndef MK_MULTI
#define MK_MULTI 0
#endif
#ifndef PROBE_REP
#define PROBE_REP 0
#endif
#ifndef USE_XCD_BAR
#define USE_XCD_BAR 1
#endif
#ifndef MK_SP2
#define MK_SP2 true
#endif
#ifndef RG_PREFETCH
#define RG_PREFETCH 1
#endif
#ifndef MK_ALIGN
#define MK_ALIGN true
#endif
__device__ __forceinline__ int mk_opaque_tid() { int t = threadIdx.x; asm volatile("" : "+v"(t)); return t; }
namespace pg8 {
#define PG8_LAS __attribute__((address_space(3)))
typedef unsigned short bf16_t;
typedef short bf16x8 __attribute__((ext_vector_type(8)));
typedef float f32x4 __attribute__((ext_vector_type(4)));
typedef unsigned u32x4 __attribute__((ext_vector_type(4)));
constexpr int BM = 256, BK = 64, HALF = 128, HTB = HALF * BK * 2  , STAGE_BYTES = 8 * HTB, NXCD = 8, WGM = 8;

__host__ __device__ __forceinline__ int lds_byte(int r, int c) { const int st = (r >> 4) * 2 + (c >> 5), rr = r & 15, cc = c & 31, ob = rr * 64 + cc * 2; return st * 1024 + (ob ^ (((ob >> 9) & 1) << 5)); }
__host__ __device__ __forceinline__ void stage_rc(int b, int& R, int& C) { const int st = b / 1024, sb = b % 1024, swz = sb ^ (((sb >> 9) & 1) << 5); R = (st >> 1) * 16 + swz / 64; C = (st & 1) * 32 + (swz % 64) / 2; }
__host__ __device__ __forceinline__ int perm32(int rho) { const int n = rho >> 4, i = rho & 15; return 8 * (i >> 2) + 4 * n + (i & 3); }

struct Unit { int pm, pn, ks, sw; };
struct Gemm { const bf16_t* A; const bf16_t* Bt; int M, N, K, ld; };

struct StaticOrder {
    int nM, nN, nwg, G, c;
    __host__ __device__ void init(int M, int N, int G_, int c_) { nM = M / BM; nN = N / BM; nwg = nM * nN; G = G_; c = c_; }
    __host__ __device__ bool next(int i, Unit& u) const {
        const long L = (long)i * G + c; if (L >= nwg) return false;
        int wgid = (int)L; { const int q = nwg / NXCD, r = nwg % NXCD, xcd = wgid % NXCD, off = wgid / NXCD; wgid = (xcd < r ? xcd * (q + 1) : r * (q + 1) + (xcd - r) * q) + off; }
        const int nig = WGM * nN, gid = wgid / nig, fm = gid * WGM, gsz = (nM - fm) < WGM ? (nM - fm) : WGM;
        u.pm = fm + ((wgid % nig) % gsz); u.pn = (wgid % nig) / gsz; u.ks = 0; u.sw = 0; return true;
    }
    __device__ __forceinline__ void a_ready(const Unit&) const {}
    __device__ __forceinline__ void done(const Unit&) const {}
};
struct SplitOrder {
    int pm0, nN, nks, total, G, c;
    __host__ __device__ void init(int pm0_, int nM_, int nN_, int nks_, int G_, int c_) { pm0 = pm0_; nN = nN_; nks = nks_; total = nM_ * nN_ * nks_; G = G_; c = c_; }
    __host__ __device__ bool next(int i, Unit& u) const { const long L = (long)i * G + c; if (L >= total) return false; const int l = (int)L; u.ks = l % nks; u.sw = 0; const int t = l / nks; u.pm = pm0 + t / nN; u.pn = t % nN; return true; }
    __device__ __forceinline__ void a_ready(const Unit&) const {}
    __device__ __forceinline__ void done(const Unit&) const {}
};
struct MergedOrder {
    int G, c;
    __host__ __device__ void init(int G_, int c_) { G = G_; c = c_; }
    __host__ __device__ bool next(int i, Unit& u) const { const long L = (long)i * G + c; if (L >= 680) return false; const int l = (int)L, w = (l % 8) * 85 + l / 8;
        u.ks = 0; if (w < 408) { u.sw = 1; u.pm = w % 6; u.pn = w / 6; } else { const int t = w - 408; u.sw = 0; u.pm = t / 4; u.pn = 6 + t % 4; } return true; }
    __device__ __forceinline__ void a_ready(const Unit&) const {}
    __device__ __forceinline__ void done(const Unit&) const {}
};
__device__ __forceinline__ unsigned cvt_pk_bf16(float lo, float hi) { unsigned r; asm volatile("v_cvt_pk_bf16_f32 %0, %1, %2" : "=v"(r) : "v"(lo), "v"(hi)); return r; }
template <class Epi, class Sched, bool ALIGN_EPI = false, bool SP2 = false>
__device__ __forceinline__ void gemm_phase(PG8_LAS unsigned char* lds, const Gemm g, const Sched& S, const Epi& E) {
    const int tid = mk_opaque_tid(), wid = __builtin_amdgcn_readfirstlane(tid >> 6), lane = tid & 63, wr = wid >> 2, wc = wid & 3, fr = lane & 15, fq = lane >> 4;
    const int K = g.K, nt = K / BK;
    unsigned voffA[2], voffB[2];
#pragma unroll
    for (int i = 0; i < 2; ++i) { int R, C; stage_rc(tid * 16 + i * 8192, R, C); const int Rb = Epi::PERM ? ((R & ~31) + perm32(R & 31)) : R;
        voffA[i] = (unsigned)(R * g.ld + C) * 2u; voffB[i] = (unsigned)(Rb * g.ld + C) * 2u; }
    const size_t kstep = (size_t)(BK * 2);
    const size_t hstep = (size_t)HALF * g.ld * 2;
    const size_t tstep = 2 * hstep;
    const unsigned ldsw = (unsigned)wid * 1024u;
    const int aoff = lds_byte(wr * 64 + fr, fq * 8), boff = lds_byte(wc * 32 + fr, fq * 8);
#define PG8_SA(b, h) (((b) * 2 + (h)) * HTB)
#define PG8_SB(b, h) ((4 + (b) * 2 + (h)) * HTB)
#define PG8_STAGE(bufoff, gbase, voff) do { _Pragma("unroll") for (int _i = 0; _i < 2; ++_i) \
        __builtin_amdgcn_global_load_lds((const unsigned*)((const char*)(gbase) + (voff)[_i]), (PG8_LAS unsigned*)(lds + (bufoff) + ldsw + _i * 8192), 16, 0, 0); } while (0)
#define PG8_LDA(dst, b, h) do { _Pragma("unroll") for (int m = 0; m < 4; ++m) _Pragma("unroll") for (int k = 0; k < 2; ++k) dst[m][k] = *(const PG8_LAS bf16x8*)(lds + PG8_SA(b, h) + aoff + m * 2048 + k * 1024); } while (0)
#define PG8_LDB(dst, b, h) do { _Pragma("unroll") for (int n = 0; n < 2; ++n) _Pragma("unroll") for (int k = 0; k < 2; ++k) dst[n][k] = *(const PG8_LAS bf16x8*)(lds + PG8_SB(b, h) + boff + n * 2048 + k * 1024); } while (0)
#define PG8_MMA(ai, bj, At, Bt) do { __builtin_amdgcn_s_setprio(1); _Pragma("unroll") for (int m = 0; m < 4; ++m) _Pragma("unroll") for (int n = 0; n < 2; ++n) _Pragma("unroll") for (int k = 0; k < 2; ++k) \
        acc[ai][bj][m][n] = __builtin_amdgcn_mfma_f32_16x16x32_bf16(Bt[n][k], At[m][k], acc[ai][bj][m][n], 0, 0, 0); __builtin_amdgcn_s_setprio(0); } while (0)
#define PG8_WAIT_V(n) asm volatile("s_waitcnt vmcnt(" #n ")" ::: "memory")
#define PG8_WAIT_L(n) asm volatile("s_waitcnt lgkmcnt(" #n ")" ::: "memory")
#define PG8_BAR __builtin_amdgcn_s_barrier()
#define PG8_SCHED __builtin_amdgcn_sched_barrier(0)
    Unit cur, nxt; int ui = 0;
    if (!S.next(0, cur)) return;
    f32x4 acc[2][2][4][2];
#pragma unroll
    for (int a = 0; a < 2; ++a)
#pragma unroll
        for (int b = 0; b < 2; ++b)
#pragma unroll
            for (int m = 0; m < 4; ++m)
#pragma unroll
                for (int n = 0; n < 2; ++n) acc[a][b][m][n] = (f32x4){0.f, 0.f, 0.f, 0.f};
    bf16x8 At[4][2], B0[2][2], B1[2][2];
    const size_t sstep = (size_t)K * 2;
    const char* cA = (const char*)(cur.sw ? g.Bt : g.A) + (size_t)cur.pm * tstep + (size_t)cur.ks * sstep; const char* cB = (const char*)(cur.sw ? g.A : g.Bt) + (size_t)cur.pn * tstep + (size_t)cur.ks * sstep;
    S.a_ready(cur);
    if constexpr (SP2) {
        PG8_STAGE(PG8_SB(0, 0), cB, voffB); PG8_STAGE(PG8_SB(0, 1), cB + hstep, voffB); PG8_STAGE(PG8_SA(0, 0), cA, voffA); PG8_STAGE(PG8_SA(0, 1), cA + hstep, voffA);
        if (wr == 1) PG8_BAR;
        PG8_WAIT_V(2); PG8_BAR;
        PG8_STAGE(PG8_SB(1, 0), cB + kstep, voffB); PG8_STAGE(PG8_SA(1, 0), cA + kstep, voffA); PG8_STAGE(PG8_SB(1, 1), cB + hstep + kstep, voffB);
        PG8_WAIT_V(6); PG8_BAR;
    } else {
        PG8_STAGE(PG8_SB(0, 0), cB, voffB); PG8_STAGE(PG8_SA(0, 0), cA, voffA); PG8_STAGE(PG8_SB(0, 1), cB + hstep, voffB); PG8_STAGE(PG8_SA(0, 1), cA + hstep, voffA);
        if (wr == 1) PG8_BAR;
        PG8_WAIT_V(4); PG8_BAR;
        PG8_STAGE(PG8_SB(1, 0), cB + kstep, voffB); PG8_STAGE(PG8_SA(1, 0), cA + kstep, voffA); PG8_STAGE(PG8_SB(1, 1), cB + hstep + kstep, voffB);
        PG8_WAIT_V(6); PG8_BAR;
    }
    for (;;) {
        const bool has_next = S.next(ui + 1, nxt);
        const char* nA = has_next ? (const char*)(nxt.sw ? g.Bt : g.A) + (size_t)nxt.pm * tstep + (size_t)nxt.ks * sstep : cA; const char* nB = has_next ? (const char*)(nxt.sw ? g.A : g.Bt) + (size_t)nxt.pn * tstep + (size_t)nxt.ks * sstep : cB;
        for (int t = 0; t < nt; t += 2) {
            const bool last = (t == nt - 2);
            const char* a1 = cA + (size_t)(t + 1) * kstep;
            const char* a2 = last ? nA : cA + (size_t)(t + 2) * kstep; const char* b2 = last ? nB : cB + (size_t)(t + 2) * kstep;
            const char* a3 = a2 + kstep; const char* b3 = b2 + kstep;
            if (last && has_next) S.a_ready(nxt);
            if constexpr (SP2) {
            PG8_LDB(B0, 0, 0); PG8_LDB(B1, 0, 1); PG8_SCHED; PG8_LDA(At, 0, 0); PG8_STAGE(PG8_SA(1, 1), a1 + hstep, voffA);
            PG8_WAIT_V(8); PG8_WAIT_L(0); PG8_BAR; PG8_MMA(0, 0, At, B0); PG8_MMA(0, 1, At, B1); PG8_BAR; PG8_SCHED;
            PG8_LDA(At, 0, 1); PG8_STAGE(PG8_SB(0, 0), b2, voffB); PG8_STAGE(PG8_SB(0, 1), b2 + hstep, voffB); PG8_STAGE(PG8_SA(0, 0), a2, voffA);
            PG8_WAIT_V(8); PG8_WAIT_L(0); PG8_BAR; PG8_MMA(1, 0, At, B0); PG8_MMA(1, 1, At, B1); PG8_BAR; PG8_SCHED;
            PG8_LDB(B0, 1, 0); PG8_LDB(B1, 1, 1); PG8_SCHED; PG8_LDA(At, 1, 0); PG8_STAGE(PG8_SA(0, 1), a2 + hstep, voffA);
            PG8_WAIT_V(8); PG8_WAIT_L(0); PG8_BAR; PG8_MMA(0, 0, At, B0); PG8_MMA(0, 1, At, B1); PG8_BAR; PG8_SCHED;
            PG8_LDA(At, 1, 1); PG8_STAGE(PG8_SB(1, 0), b3, voffB); PG8_STAGE(PG8_SB(1, 1), b3 + hstep, voffB); PG8_STAGE(PG8_SA(1, 0), a3, voffA);
            PG8_WAIT_V(8); PG8_WAIT_L(0); PG8_BAR; PG8_MMA(1, 0, At, B0); PG8_MMA(1, 1, At, B1); PG8_BAR; PG8_SCHED;
            } else {
            PG8_LDB(B0, 0, 0); PG8_SCHED; PG8_LDA(At, 0, 0); PG8_STAGE(PG8_SA(1, 1), a1 + hstep, voffA);
            PG8_WAIT_L(8); PG8_BAR; PG8_WAIT_L(0); PG8_MMA(0, 0, At, B0); PG8_BAR; PG8_SCHED;
            PG8_LDB(B1, 0, 1); PG8_STAGE(PG8_SB(0, 0), b2, voffB);
            PG8_BAR; PG8_WAIT_L(0); PG8_MMA(0, 1, At, B1); PG8_BAR;
            PG8_LDA(At, 0, 1); PG8_STAGE(PG8_SA(0, 0), a2, voffA);
            PG8_BAR; PG8_WAIT_L(0); PG8_MMA(1, 0, At, B0); PG8_BAR; PG8_SCHED;
            PG8_STAGE(PG8_SB(0, 1), b2 + hstep, voffB);
            PG8_WAIT_V(6); PG8_BAR; PG8_MMA(1, 1, At, B1); PG8_BAR;
            PG8_LDB(B0, 1, 0); PG8_SCHED; PG8_LDA(At, 1, 0); PG8_STAGE(PG8_SA(0, 1), a2 + hstep, voffA);
            PG8_WAIT_L(8); PG8_BAR; PG8_WAIT_L(0); PG8_MMA(0, 0, At, B0); PG8_BAR; PG8_SCHED;
            PG8_LDB(B1, 1, 1); PG8_STAGE(PG8_SB(1, 0), b3, voffB);
            PG8_BAR; PG8_WAIT_L(0); PG8_MMA(0, 1, At, B1); PG8_BAR;
            PG8_LDA(At, 1, 1); PG8_STAGE(PG8_SA(1, 0), a3, voffA);
            PG8_BAR; PG8_WAIT_L(0); PG8_MMA(1, 0, At, B0); PG8_BAR; PG8_SCHED;
            PG8_STAGE(PG8_SB(1, 1), b3 + hstep, voffB);
            PG8_WAIT_V(6); PG8_BAR; PG8_MMA(1, 1, At, B1); PG8_BAR;
            }
        }
        if constexpr (ALIGN_EPI) { if (wr == 0) PG8_BAR; }
        if constexpr (!Epi::AFTER_DRAIN) { E(acc, cur, wr, wc, fr, fq); S.done(cur); }
        if (!has_next) break;
#pragma unroll
        for (int a = 0; a < 2; ++a)
#pragma unroll
            for (int b = 0; b < 2; ++b)
#pragma unroll
                for (int m = 0; m < 4; ++m)
#pragma unroll
                    for (int n = 0; n < 2; ++n) acc[a][b][m][n] = (f32x4){0.f, 0.f, 0.f, 0.f};
        cur = nxt; cA = nA; cB = nB; ++ui;
        if constexpr (ALIGN_EPI) { if (wr == 1) PG8_BAR; }
    }
    PG8_WAIT_V(0);
    if constexpr (!ALIGN_EPI) { if (wr == 0) PG8_BAR; }
    PG8_BAR;
    if constexpr (Epi::AFTER_DRAIN) { E.fused(acc, cur, wr, wc, fr, fq, lds, wid, lane); S.done(cur); }
#undef PG8_SA
#undef PG8_SB
#undef PG8_STAGE
#undef PG8_LDA
#undef PG8_LDB
#undef PG8_MMA
#undef PG8_WAIT_V
#undef PG8_WAIT_L
#undef PG8_BAR
#undef PG8_SCHED
}
}

#define LAS __attribute__((address_space(3)))
typedef unsigned short bf16_t;
typedef float f32x4 __attribute__((ext_vector_type(4)));
typedef float f32x2 __attribute__((ext_vector_type(2)));
typedef unsigned u32x4 __attribute__((ext_vector_type(4)));
typedef unsigned u32x2 __attribute__((ext_vector_type(2)));
typedef short bf16x8 __attribute__((ext_vector_type(8)));

constexpr int D = 1024, NB = 4, SEQ = 4096, CTXL = 256, DEPTH = 4;
constexpr int ML = NB * SEQ, MC = NB * CTXL, MT = ML + MC;
constexpr int NEIN = 2560, DRNN = 1408, NOIN = 2816, DFF = 2816, NFFN = 5632, NMOD = 6144;
constexpr int NT_ALL = SEQ + CTXL;
constexpr float EPS = 1e-6f;
constexpr int NTHR = 512, NWAVES = 8;
constexpr int LDS_BYTES = 147456;

constexpr size_t MiB = 1u << 20;
constexpr size_t WS_MOD = 0;
constexpr size_t WS_BAR = 512 * 1024;
constexpr size_t WS_HDN = 1 * MiB;
constexpr size_t WS_RGW = 4 * MiB;
constexpr size_t WS_XSC = 8 * MiB;
constexpr size_t WS_W   = 12 * MiB;
constexpr size_t WS_H   = 109 * MiB;
constexpr size_t WS_Z   = 143 * MiB;
constexpr size_t WS_MIX = 237 * MiB;
constexpr size_t WS_HB  = 284 * MiB;
constexpr size_t WS_XS16 = 331 * MiB;
constexpr size_t WS_END = 365 * MiB;
__host__ __device__ constexpr size_t W_FFNIN(int l)  { return WS_W + (size_t)l * (33 * MiB / 2); }
__host__ __device__ constexpr size_t W_FFNOUT(int l) { return W_FFNIN(l) + 11 * MiB; }
__host__ __device__ constexpr size_t W_EIN(int i)    { return WS_W + 66 * MiB + (size_t)i * 7 * MiB; }
__host__ __device__ constexpr size_t W_EOUT(int i)   { return W_EIN(i) + 5 * MiB; }
__host__ __device__ constexpr size_t W_OIN(int i)    { return WS_W + 80 * MiB + (size_t)i * (33 * MiB / 4); }
__host__ __device__ constexpr size_t W_OOUT(int i)   { return W_OIN(i) + 11 * MiB / 2; }

enum { I_X = 0, I_C, I_CTX, I_CCTX, I_WADA, I_BADA, I_GMIX, I_GFFN, I_WINE, I_WOUTE, I_HCW, I_HCB, I_F1W, I_F1B, I_F2W, I_F2B, I_F3W, I_F3B, I_SINF, I_SKIP,
       I_LNG, I_SGUW, I_SGUB, I_WINO, I_RCW, I_RCB, I_RWA, I_RBA, I_RWX, I_RBX, I_LAM, I_WOUTO, I_WFIN, I_WFOUT, I_FING, N_IN };
struct Args { const float* in[N_IN]; float* out; unsigned char* ws; int ph_lo, ph_hi; };
typedef const __attribute__((address_space(4))) Args* KA;

__device__ __forceinline__ unsigned f2bf(float f) { unsigned u = __builtin_bit_cast(unsigned, f); return (u + 0x7fffu + ((u >> 16) & 1u)) >> 16; }
__device__ __forceinline__ unsigned pk2(float lo, float hi) { return pg8::cvt_pk_bf16(lo, hi); }
__device__ __forceinline__ float bf2f(unsigned h) { return __builtin_bit_cast(float, h << 16); }
__device__ __forceinline__ float bflo(unsigned w) { return __builtin_bit_cast(float, w << 16); }
__device__ __forceinline__ float bfhi(unsigned w) { return __builtin_bit_cast(float, w & 0xffff0000u); }
__device__ __forceinline__ float wave_sum(float v) {
#pragma unroll
    for (int o = 1; o < 64; o <<= 1) v += __shfl_xor(v, o);
    return v;
}
__device__ __forceinline__ float sigmoidf_(float x) { return __builtin_amdgcn_rcpf(1.0f + __builtin_amdgcn_exp2f(-1.4426950408889634f * x)); }
__device__ __forceinline__ float silu_(float x) { return x * sigmoidf_(x); }
__device__ __forceinline__ float gelu_tanh(float x) {
    const float q = __builtin_fmaf(x * x, -0.10294324f, -2.3022082f); return x * __builtin_amdgcn_rcpf(1.0f + __builtin_amdgcn_exp2f(x * q)); }
__device__ __forceinline__ float* xs_row(KA a, int row) { return row < ML ? a->out + (size_t)row * D : (float*)(a->ws + WS_XSC) + (size_t)(row - ML) * D; }

#define XB_TMO      128
#define XB_XCNT(j)  (256  + 64 * (j))
#define XB_XSUB(j)  (1280 + 64 * (j))
#define XB_XGEN(j)  (2304 + 64 * (j))
#define XB_TOP      3328
#define XB_TOPGEN   3392
#define XCD_BAR_WORDS 3456
#define XB_SPIN_CAP (1u << 18)

__device__ __forceinline__ unsigned xb_ld(unsigned* p)              { return __hip_atomic_load(p, __ATOMIC_RELAXED, __HIP_MEMORY_SCOPE_AGENT); }
__device__ __forceinline__ unsigned xb_add(unsigned* p, unsigned v) { return __hip_atomic_fetch_add(p, v, __ATOMIC_RELAXED, __HIP_MEMORY_SCOPE_AGENT); }
__device__ __forceinline__ unsigned xb_xcc_id() { return (unsigned)__builtin_amdgcn_s_getreg((3 << 11) | 20) & 0xFu; }
#define XB_SPIN(cond, bar) do { unsigned _sp = 0; while (cond) { __builtin_amdgcn_s_sleep(1); \
    if ((++_sp & 255u) == 0u) { if (xb_ld(&(bar)[XB_TMO])) break; if (_sp > XB_SPIN_CAP) { atomicAdd(&(bar)[XB_TMO], 1u); break; } } } } while (0)

struct XcdBarrier {
    unsigned* bar; unsigned x;
    volatile LAS unsigned* st;
};

__device__ __forceinline__ XcdBarrier xcd_barrier_post(unsigned* bar, volatile LAS unsigned* st) {
    XcdBarrier b; b.bar = bar; b.x = xb_xcc_id(); b.st = st;
    if (threadIdx.x == 0) (void)xb_add(&bar[XB_XCNT(b.x)], 1u);
    return b;
}
__device__ __forceinline__ void xcd_barrier_complete(unsigned* bar, unsigned x, unsigned& nloc, unsigned& nx) {
    const unsigned G = gridDim.x * gridDim.y * gridDim.z;
    unsigned sum, cnt, mine, sp = 0u;
    for (;;) {
        sum = 0u; cnt = 0u; mine = 0u;
#pragma unroll
        for (unsigned j = 0; j < 16; ++j) { const unsigned c = xb_ld(&bar[XB_XCNT(j)]); sum += c; cnt += (c > 0u) ? 1u : 0u; mine = (j == x) ? c : mine; }
        if (sum == G) break;
        __builtin_amdgcn_s_sleep(1);
        if ((++sp & 255u) == 0u) { if (xb_ld(&bar[XB_TMO])) break; if (sp > XB_SPIN_CAP) { atomicAdd(&bar[XB_TMO], 1u); break; } }
    }
    nloc = mine > 0u ? mine : 1u; nx = cnt > 0u ? cnt : 1u;
}

__device__ __forceinline__ void xcd_barrier(const XcdBarrier& b) {
    asm volatile("s_waitcnt vmcnt(0)" ::: "memory");
    __syncthreads();
    if (threadIdx.x == 0) {
        unsigned* bar = b.bar;
        __builtin_amdgcn_s_waitcnt(0);
        unsigned nloc = b.st[0], nx = b.st[1];
        if (nloc == 0u) { xcd_barrier_complete(bar, b.x, nloc, nx); b.st[0] = nloc; b.st[1] = nx; }
        const unsigned old = xb_add(&bar[XB_XSUB(b.x)], 1u);
        const unsigned gen = old / nloc;
        if (old + 1u == (gen + 1u) * nloc) {
            __builtin_amdgcn_fence(__ATOMIC_RELEASE, "agent");
            asm volatile("s_waitcnt vmcnt(0)" ::: "memory");
            const unsigned og = xb_add(&bar[XB_TOP], 1u);
            const unsigned tg = og / nx;
            if (og + 1u == (tg + 1u) * nx) xb_add(&bar[XB_TOPGEN], 1u);
            else XB_SPIN(xb_ld(&bar[XB_TOPGEN]) == tg, bar);
            __builtin_amdgcn_fence(__ATOMIC_ACQUIRE, "agent");
            xb_add(&bar[XB_XGEN(b.x)], 1u);
            asm volatile("s_waitcnt vmcnt(0)" ::: "memory");
        } else {
            XB_SPIN(xb_ld(&bar[XB_XGEN(b.x)]) == gen, bar);
            __builtin_amdgcn_fence(__ATOMIC_ACQUIRE, "agent");
            asm volatile("s_waitcnt vmcnt(0)" ::: "memory");
        }
    }
    __syncthreads();
}

struct EpiStore {
    static constexpr bool PERM = true, AFTER_DRAIN = false;
    bf16_t* O_; int ldc_; int gelu_blocks_;  bf16_t* O2; int ldc2;
    __device__ __forceinline__ void operator()(const f32x4 (&acc)[2][2][4][2], const pg8::Unit& u, int wr, int wc, int fr, int fq) const {
        bf16_t* O = u.sw ? O2 : O_; const int ldc = u.sw ? ldc2 : ldc_, gelu_blocks = u.sw ? 0 : gelu_blocks_;
        const int row0 = u.pm * 256 + wr * 64 + fr, col0 = u.pn * 256 + wc * 32 + 8 * fq;
#pragma unroll
        for (int ai = 0; ai < 2; ++ai)
#pragma unroll
            for (int m = 0; m < 4; ++m) { bf16_t* rowp = O + (size_t)(row0 + ai * 128 + m * 16) * ldc + col0;
#pragma unroll
                for (int bj = 0; bj < 2; ++bj) { f32x4 v0 = acc[ai][bj][m][0], v1 = acc[ai][bj][m][1];
                    if (2 * u.pn + bj < gelu_blocks) {
#pragma unroll
                        for (int j = 0; j < 4; ++j) { v0[j] = gelu_tanh(v0[j]); v1[j] = gelu_tanh(v1[j]); } }
                    u32x4 w; w.x = pk2(v0[0], v0[1]); w.y = pk2(v0[2], v0[3]); w.z = pk2(v1[0], v1[1]); w.w = pk2(v1[2], v1[3]);
                    *(u32x4*)(rowp + bj * 128) = w; } }
    }
};
struct EpiFFN {
    static constexpr bool PERM = true, AFTER_DRAIN = false;
    bf16_t* O;
    __device__ __forceinline__ void operator()(const f32x4 (&acc)[2][2][4][2], const pg8::Unit& u, int wr, int wc, int fr, int fq) const {
        const int row0 = u.pm * 256 + wr * 64 + fr, col0 = u.pn * 128 + wc * 32 + 8 * fq;
#pragma unroll
        for (int ai = 0; ai < 2; ++ai)
#pragma unroll
            for (int m = 0; m < 4; ++m) { bf16_t* rowp = O + (size_t)(row0 + ai * 128 + m * 16) * DFF + col0;
                f32x4 v0, v1;
#pragma unroll
                for (int j = 0; j < 4; ++j) { v0[j] = silu_(acc[ai][0][m][0][j]) * acc[ai][1][m][0][j]; v1[j] = silu_(acc[ai][0][m][1][j]) * acc[ai][1][m][1][j]; }
                u32x4 w; w.x = pk2(v0[0], v0[1]); w.y = pk2(v0[2], v0[3]); w.z = pk2(v1[0], v1[1]); w.w = pk2(v1[2], v1[3]);
                *(u32x4*)rowp = w; }
    }
};
struct EpiRes {
    static constexpr bool PERM = true, AFTER_DRAIN = false;
    const float* mod;    bf16_t* xs;
    const float* xsrc;
    int split;
    float* part;
    __device__ __forceinline__ void operator()(const f32x4 (&acc)[2][2][4][2], const pg8::Unit& u, int wr, int wc, int fr, int fq) const {
        const int row0 = u.pm * 256 + wr * 64 + fr, col0 = u.pn * 256 + wc * 32 + 8 * fq;
        const int mrow = u.pm < 64 ? (u.pm >> 4) : 4;
        const float* mp = mod + mrow * NMOD + col0;
        f32x4 mv[2][2];
#pragma unroll
        for (int bj = 0; bj < 2; ++bj)
#pragma unroll
            for (int n = 0; n < 2; ++n) mv[bj][n] = *(const f32x4*)(mp + bj * 128 + n * 4);
        if (split) {
#pragma unroll
            for (int ai = 0; ai < 2; ++ai)
#pragma unroll
                for (int m = 0; m < 4; ++m) { const int r = row0 + ai * 128 + m * 16;
                    float* pp = part + ((size_t)u.ks * MC + (size_t)(r - ML)) * D + col0;
#pragma unroll
                    for (int bj = 0; bj < 2; ++bj) { *(f32x4*)(pp + bj * 128) = acc[ai][bj][m][0]; *(f32x4*)(pp + bj * 128 + 4) = acc[ai][bj][m][1]; } }
        } else if (xsrc) {
#pragma unroll
            for (int ai = 0; ai < 2; ++ai)
#pragma unroll
                for (int m = 0; m < 4; ++m) { const int r = row0 + ai * 128 + m * 16; bf16_t* xp = xs + (size_t)r * D + col0;
#pragma unroll
                    for (int bj = 0; bj < 2; ++bj) { const float* sp = xsrc + (size_t)r * D + col0 + bj * 128; f32x4 o0 = *(const f32x4*)sp, o1 = *(const f32x4*)(sp + 4);
                        o0 += mv[bj][0] * acc[ai][bj][m][0]; o1 += mv[bj][1] * acc[ai][bj][m][1];
                        u32x4 w2; w2.x = pk2(o0.x, o0.y); w2.y = pk2(o0.z, o0.w); w2.z = pk2(o1.x, o1.y); w2.w = pk2(o1.z, o1.w);
                        *(u32x4*)(xp + bj * 128) = w2; }
                    asm volatile("" ::: "memory"); }
        } else {
#pragma unroll
            for (int ai = 0; ai < 2; ++ai) {
                u32x4 oldw[4][2];
#pragma unroll
                for (int m = 0; m < 4; ++m)
#pragma unroll
                    for (int bj = 0; bj < 2; ++bj) oldw[m][bj] = *(const u32x4*)(xs + (size_t)(row0 + ai * 128 + m * 16) * D + col0 + bj * 128);
#pragma unroll
                for (int m = 0; m < 4; ++m) { bf16_t* xp = xs + (size_t)(row0 + ai * 128 + m * 16) * D + col0;
#pragma unroll
                    for (int bj = 0; bj < 2; ++bj) { const u32x4 w = oldw[m][bj];
                        f32x4 o0 = (f32x4){bflo(w.x), bfhi(w.x), bflo(w.y), bfhi(w.y)}, o1 = (f32x4){bflo(w.z), bfhi(w.z), bflo(w.w), bfhi(w.w)};
                        o0 += mv[bj][0] * acc[ai][bj][m][0]; o1 += mv[bj][1] * acc[ai][bj][m][1];
                        u32x4 w2; w2.x = pk2(o0.x, o0.y); w2.y = pk2(o0.z, o0.w); w2.z = pk2(o1.x, o1.y); w2.w = pk2(o1.z, o1.w);
                        *(u32x4*)(xp + bj * 128) = w2; } }
                asm volatile("" ::: "memory");
            }
        }
    }
};

__device__ __forceinline__ void p0_transpose_item(const float* W, int K, int N, bf16_t* WT, int mode, LAS float* scr, int item, int lane) {
    const int nblk = N / 32, kb = item / nblk, nb = item % nblk, k0 = 64 * kb, n0 = 32 * nb;
    int rowbase = n0;
    if (mode == 1) { const int half = n0 >= DFF ? 1 : 0, nn = n0 - half * DFF; rowbase = 256 * (nn >> 7) + 128 * half + (nn & 127); }
#pragma unroll 8
    for (int i = 0; i < 32; ++i) { const int kk = 2 * i + (lane >> 5); scr[kk * 33 + (lane & 31)] = W[(size_t)(k0 + kk) * N + n0 + (lane & 31)]; }
    asm volatile("s_waitcnt lgkmcnt(0)" ::: "memory");
    const int c = lane & 7;
#pragma unroll
    for (int j = 0; j < 4; ++j) { const int n = (lane >> 3) + 8 * j; const LAS float* s = scr + (8 * c) * 33 + n;
        u32x4 o; o.x = pk2(s[0 * 33], s[1 * 33]); o.y = pk2(s[2 * 33], s[3 * 33]); o.z = pk2(s[4 * 33], s[5 * 33]); o.w = pk2(s[6 * 33], s[7 * 33]);
        *(u32x4*)(WT + (size_t)(rowbase + n) * K + k0 + 8 * c) = o; }
    asm volatile("s_waitcnt lgkmcnt(0)" ::: "memory");
}

struct P0Item { const float* W; bf16_t* WT; int K, N, k0, n0, rowbase; };
__device__ __forceinline__ P0Item p0_make(const float* W, int K, int N, bf16_t* WT, int mode, int item) {
    P0Item q; q.W = W; q.WT = WT; q.K = K; q.N = N; const int nblk = N / 32, kb = item / nblk, nb = item % nblk; q.k0 = 64 * kb; q.n0 = 32 * nb; q.rowbase = q.n0;
    if (mode == 1) { const int half = q.n0 >= DFF ? 1 : 0, nn = q.n0 - half * DFF; q.rowbase = 256 * (nn >> 7) + 128 * half + (nn & 127); }
    return q;
}
__device__ __forceinline__ P0Item p0_decode(KA a, int it) {
    unsigned char* ws = a->ws;
    if (it < 16896) { const int l = it / 4224, r = it % 4224;
        if (r < 2816) return p0_make(a->in[I_WFIN] + (size_t)l * D * NFFN, D, NFFN, (bf16_t*)(ws + W_FFNIN(l)), 1, r);
        return p0_make(a->in[I_WFOUT] + (size_t)l * DFF * D, DFF, D, (bf16_t*)(ws + W_FFNOUT(l)), 0, r - 2816); }
    it -= 16896;
    if (it < 3584) { const int i = it / 1792, r = it % 1792;
        if (r < 1280) return p0_make(a->in[I_WINE] + (size_t)i * D * NEIN, D, NEIN, (bf16_t*)(ws + W_EIN(i)), 0, r);
        return p0_make(a->in[I_WOUTE] + (size_t)i * D * D, D, D, (bf16_t*)(ws + W_EOUT(i)), 0, r - 1280); }
    it -= 3584;
    { const int i = it / 2112, r = it % 2112;
        if (r < 1408) return p0_make(a->in[I_WINO] + (size_t)i * D * NOIN, D, NOIN, (bf16_t*)(ws + W_OIN(i)), 0, r);
        return p0_make(a->in[I_WOUTO] + (size_t)i * DRNN * D, DRNN, D, (bf16_t*)(ws + W_OOUT(i)), 0, r - 1408); }
}
__device__ __forceinline__ void p0_store_item(const P0Item& q, const float (&r)[32], LAS float* scr, int lane) {
#pragma unroll
    for (int i = 0; i < 32; ++i) scr[(2 * i + (lane >> 5)) * 33 + (lane & 31)] = r[i];
    asm volatile("s_waitcnt lgkmcnt(0)" ::: "memory");
    const int c = lane & 7;
#pragma unroll
    for (int j = 0; j < 4; ++j) { const int n = (lane >> 3) + 8 * j; const LAS float* s = scr + (8 * c) * 33 + n;
        u32x4 o; o.x = pk2(s[0 * 33], s[1 * 33]); o.y = pk2(s[2 * 33], s[3 * 33]); o.z = pk2(s[4 * 33], s[5 * 33]); o.w = pk2(s[6 * 33], s[7 * 33]);
        *(u32x4*)(q.WT + (size_t)(q.rowbase + n) * q.K + q.k0 + 8 * c) = o; }
    asm volatile("s_waitcnt lgkmcnt(0)" ::: "memory");
}
__device__ __forceinline__ void phase0(KA a, LAS unsigned char* lds, int tid, int lane, int wave, int bid, int G) {
    unsigned char* ws = a->ws;
    {
        LAS float* sv = (LAS float*)lds;
        LAS float* part = (LAS float*)(lds + 32768);
        for (int i = tid; i < 5 * 1024; i += NTHR) { const int r = i >> 10, k = i & 1023; const float v = (r < 4) ? a->in[I_C][r * 1024 + k] : a->in[I_CCTX][k]; sv[i] = silu_(v); }
        __syncthreads();
        float* mod = (float*)(ws + WS_MOD);
        for (int it = bid; it < 192; it += G) {
            const int l = it / 48, n0 = (it % 48) * 128;
            const float* W = a->in[I_WADA] + (size_t)l * 1024 * NMOD;
            const int cgp = lane & 31, kp = lane >> 5;
            f32x4 acc[5];
#pragma unroll
            for (int r = 0; r < 5; ++r) acc[r] = (f32x4){0.f, 0.f, 0.f, 0.f};
#pragma unroll 16
            for (int i = 0; i < 64; ++i) { const int k = wave * 128 + 2 * i + kp; const f32x4 w = __builtin_nontemporal_load((const f32x4*)(W + (size_t)k * NMOD + n0 + 4 * cgp));
#pragma unroll
                for (int r = 0; r < 5; ++r) acc[r] += sv[r * 1024 + k] * w; }
            const int slot = wave * 2 + kp;
#pragma unroll
            for (int r = 0; r < 5; ++r) *(LAS f32x4*)(part + (slot * 5 + r) * 128 + 4 * cgp) = acc[r];
            __syncthreads();
            for (int o = tid; o < 640; o += NTHR) { const int r = o >> 7, n = o & 127; float s = a->in[I_BADA][l * NMOD + n0 + n];
#pragma unroll
                for (int sl = 0; sl < 16; ++sl) s += part[(sl * 5 + r) * 128 + n];
                mod[(size_t)(l * 5 + r) * NMOD + n0 + n] = s; }
            __syncthreads();
        }
    }
    {
        LAS float* scr0 = (LAS float*)(lds + wave * 17408); LAS float* scr1 = scr0 + 2176;
        const int gw = bid * NWAVES + wave, NGW = G * NWAVES;
        for (int it0 = gw; it0 < 24704; it0 += 2 * NGW) {
            float ra[32], rb[32]; P0Item A = p0_decode(a, it0), B = p0_decode(a, it0 + NGW < 24704 ? it0 + NGW : it0);
            const bool two = it0 + NGW < 24704;
#pragma unroll
            for (int i = 0; i < 32; ++i) ra[i] = __builtin_nontemporal_load(&A.W[(size_t)(A.k0 + 2 * i + (lane >> 5)) * A.N + A.n0 + (lane & 31)]);
            if (two) {
#pragma unroll
                for (int i = 0; i < 32; ++i) rb[i] = __builtin_nontemporal_load(&B.W[(size_t)(B.k0 + 2 * i + (lane >> 5)) * B.N + B.n0 + (lane & 31)]);
            }
            p0_store_item(A, ra, scr0, lane);
            if (two) p0_store_item(B, rb, scr1, lane);
        }
    }
    const size_t gt = (size_t)bid * NTHR + tid, GT = (size_t)G * NTHR;
    {
        bf16_t* rgw = (bf16_t*)(ws + WS_RGW);
        for (size_t idx = gt; idx < 1179648; idx += GT) {
            const int d = (int)(idx % 96), e = (int)((idx / 96) % 96), hh = (int)((idx / 9216) % 16), mat = (int)((idx / 147456) % 2), dir = (int)((idx / 294912) % 2), i = (int)(idx / 589824);
            float v = 0.f;
            if (d < 88 && e < 88) { const float* src = mat ? a->in[I_RWX] : a->in[I_RWA]; v = src[((size_t)((i * 2 + dir) * 16 + hh) * 88 + d) * 88 + e]; }
            rgw[idx] = (bf16_t)f2bf(v);
        }
    }
    {
        float* hdn = (float*)(ws + WS_HDN);
        const int gw = bid * NWAVES + wave, NGW = G * NWAVES;
        for (int it = gw; it < 2 * NT_ALL; it += NGW) {
            const int i = it / NT_ALL, ta = it % NT_ALL;
            const int L = ta < SEQ ? SEQ : CTXL, pos = ta < SEQ ? ta : ta - SEQ;
            const float tn = (float)pos / (float)(L - 1);
            const float w = (6.283185307179586f * (float)pos) / (float)L;
            float ev = 0.f;
            if (lane == 0) ev = tn;
            else if (lane < 17) { const float f = 1e-4f + (float)(lane - 1) * ((15.0f - 1e-4f) / 15.0f); ev = cosf(f * w); }
            else if (lane < 33) { const float f = 1e-4f + (float)(lane - 17) * ((15.0f - 1e-4f) / 15.0f); ev = -sinf(f * w); }
            float s = a->in[I_F1B][i * 64 + lane];
#pragma unroll
            for (int e = 0; e < 33; ++e) s += __shfl(ev, e) * a->in[I_F1W][(size_t)(i * 33 + e) * 64 + lane];
            const float sf = a->in[I_SINF][i * 64 + lane];
            const float h1 = sinf(sf * s);
            float s2 = a->in[I_F2B][i * 64 + lane];
#pragma unroll 16
            for (int k = 0; k < 64; ++k) s2 += __shfl(h1, k) * a->in[I_F2W][(size_t)(i * 64 + k) * 64 + lane];
            hdn[(size_t)(i * NT_ALL + ta) * 64 + lane] = sinf(sf * s2);
        }
    }
    {
        const f32x4* cs = (const f32x4*)a->in[I_CTX]; u32x2* co = (u32x2*)((bf16_t*)(ws + WS_XS16) + (size_t)ML * D);
        for (size_t i = gt; i < (size_t)MC * D / 4; i += GT) { const f32x4 v = cs[i]; u32x2 w; w.x = pk2(v.x, v.y); w.y = pk2(v.z, v.w); co[i] = w; }
    }
}

__device__ __forceinline__ void xs_load16(const bf16_t* xr, const float* fr, int lane, f32x4 (&v)[4]) {
#pragma unroll
    for (int j = 0; j < 2; ++j) {
        if (fr) { v[2 * j] = *(const f32x4*)(fr + 8 * lane + 512 * j); v[2 * j + 1] = *(const f32x4*)(fr + 8 * lane + 512 * j + 4); }
        else { const u32x4 w = *(const u32x4*)(xr + 8 * lane + 512 * j); v[2 * j] = (f32x4){bflo(w.x), bfhi(w.x), bflo(w.y), bfhi(w.y)}; v[2 * j + 1] = (f32x4){bflo(w.z), bfhi(w.z), bflo(w.w), bfhi(w.w)}; } }
}
__device__ __forceinline__ void xs_raw16(const bf16_t* xr, const float* fr, int lane, u32x4 (&q)[4]) {
    if (fr) {
#pragma unroll
        for (int j = 0; j < 2; ++j) { q[2 * j] = *(const u32x4*)(fr + 8 * lane + 512 * j); q[2 * j + 1] = *(const u32x4*)(fr + 8 * lane + 512 * j + 4); } }
    else { q[0] = *(const u32x4*)(xr + 8 * lane); q[1] = *(const u32x4*)(xr + 8 * lane + 512); }
}
__device__ __forceinline__ void xs_cvt16(const u32x4 (&q)[4], bool isf32, f32x4 (&v)[4]) {
    if (isf32) {
#pragma unroll
        for (int k = 0; k < 4; ++k) v[k] = __builtin_bit_cast(f32x4, q[k]); }
    else {
#pragma unroll
        for (int j = 0; j < 2; ++j) { const u32x4 w = q[j]; v[2 * j] = (f32x4){bflo(w.x), bfhi(w.x), bflo(w.y), bfhi(w.y)}; v[2 * j + 1] = (f32x4){bflo(w.z), bfhi(w.z), bflo(w.w), bfhi(w.w)}; } }
}
__device__ __forceinline__ void phase_norm(KA a, int l, int csh, const float* g, int lane, int gw, int NGW, int nks, const float* gate) {
    const float* mod = (const float*)(a->ws + WS_MOD) + (size_t)l * 5 * NMOD;
    bf16_t* H = (bf16_t*)(a->ws + WS_H); bf16_t* XS = (bf16_t*)(a->ws + WS_XS16);
    const bool l0 = (l == 0 && csh == 0);
    u32x4 qn[4] = {};
    if (gw < MT) xs_raw16(XS + (size_t)gw * D, (l0 && gw < ML) ? a->in[I_X] + (size_t)gw * D : nullptr, lane, qn);
    f32x4 ggv[4], shc[4], scc[4]; int cur_mrow = -1;
#pragma unroll
    for (int q = 0; q < 4; ++q) { ggv[q] = *(const f32x4*)(g + 8 * lane + 512 * (q >> 1) + 4 * (q & 1)); shc[q] = ggv[q]; scc[q] = ggv[q]; }
    for (int row = gw; row < MT; row += NGW) {
        const int mrow = row < ML ? (row >> 12) : 4;
        if (mrow != cur_mrow) { cur_mrow = mrow; const float* shp = mod + mrow * NMOD + csh * 1024 + 8 * lane;
#pragma unroll
            for (int q = 0; q < 4; ++q) { const int off = 512 * (q >> 1) + 4 * (q & 1); shc[q] = *(const f32x4*)(shp + off); scc[q] = *(const f32x4*)(shp + 1024 + off) + 1.0f; } }
        f32x4 v[4]; float s = 0.f;
        u32x4 qc[4];
#pragma unroll
        for (int k = 0; k < 4; ++k) qc[k] = qn[k];
        { const int nr = row + NGW; if (nr < MT) xs_raw16(XS + (size_t)nr * D, (l0 && nr < ML) ? a->in[I_X] + (size_t)nr * D : nullptr, lane, qn); }
        xs_cvt16(qc, l0 && row < ML, v);
        if (row >= ML && nks > 0) {
            const float* pp = (const float*)(a->ws + (csh == 0 ? WS_MIX : WS_HB)) + (size_t)(row - ML) * D + 8 * lane;
            f32x4 ps[4];
#pragma unroll
            for (int q = 0; q < 4; ++q) ps[q] = (f32x4){0.f, 0.f, 0.f, 0.f};
            int ks = 0;
            for (; ks + 4 <= nks; ks += 4) {
                f32x4 t[4][4];
#pragma unroll
                for (int u = 0; u < 4; ++u)
#pragma unroll
                    for (int q = 0; q < 4; ++q) t[u][q] = *(const f32x4*)(pp + (size_t)(ks + u) * MC * D + 512 * (q >> 1) + 4 * (q & 1));
#pragma unroll
                for (int u = 0; u < 4; ++u)
#pragma unroll
                    for (int q = 0; q < 4; ++q) ps[q] += t[u][q];
            }
            for (; ks < nks; ++ks) {
                f32x4 t[4];
#pragma unroll
                for (int q = 0; q < 4; ++q) t[q] = *(const f32x4*)(pp + (size_t)ks * MC * D + 512 * (q >> 1) + 4 * (q & 1));
#pragma unroll
                for (int q = 0; q < 4; ++q) ps[q] += t[q];
            }
#pragma unroll
            for (int q = 0; q < 4; ++q) { const int off = 512 * (q >> 1) + 4 * (q & 1); v[q] += *(const f32x4*)(gate + 4 * NMOD + 8 * lane + off) * ps[q]; }
#pragma unroll
            for (int j = 0; j < 2; ++j) { u32x4 w; w.x = pk2(v[2 * j].x, v[2 * j].y); w.y = pk2(v[2 * j].z, v[2 * j].w); w.z = pk2(v[2 * j + 1].x, v[2 * j + 1].y); w.w = pk2(v[2 * j + 1].z, v[2 * j + 1].w);
                *(u32x4*)(XS + (size_t)row * D + 8 * lane + 512 * j) = w; }
        }
#pragma unroll
        for (int q = 0; q < 4; ++q) s += (v[q].x * v[q].x + v[q].y * v[q].y) + (v[q].z * v[q].z + v[q].w * v[q].w);
        const float rstd = 1.0f / sqrtf(wave_sum(s) * (1.0f / 1024.0f) + EPS);
#pragma unroll
        for (int j = 0; j < 2; ++j) { const int col = 8 * lane + 512 * j; f32x4 o[2];
#pragma unroll
            for (int h = 0; h < 2; ++h) o[h] = (v[2 * j + h] * rstd) * ggv[2 * j + h] * scc[2 * j + h] + shc[2 * j + h];
            u32x4 w; w.x = pk2(o[0].x, o[0].y); w.y = pk2(o[0].z, o[0].w); w.z = pk2(o[1].x, o[1].y); w.w = pk2(o[1].z, o[1].w);
            *(u32x4*)(H + (size_t)row * D + col) = w; }
    }
}
__device__ __forceinline__ void phase_final(KA a, int lane, int gw, int NGW) {
    const float* g = a->in[I_FING]; const bf16_t* XS = (const bf16_t*)(a->ws + WS_XS16);
    u32x4 qn[4] = {};
    if (gw < ML) xs_raw16(XS + (size_t)gw * D, nullptr, lane, qn);
    f32x4 ggv[4];
#pragma unroll
    for (int q = 0; q < 4; ++q) ggv[q] = *(const f32x4*)(g + 8 * lane + 512 * (q >> 1) + 4 * (q & 1));
    for (int row = gw; row < ML; row += NGW) {
        f32x4 v[4]; float s = 0.f;
        u32x4 qc[4];
#pragma unroll
        for (int k = 0; k < 4; ++k) qc[k] = qn[k];
        { const int nr = row + NGW; if (nr < ML) xs_raw16(XS + (size_t)nr * D, nullptr, lane, qn); }
        xs_cvt16(qc, false, v);
#pragma unroll
        for (int q = 0; q < 4; ++q) s += (v[q].x * v[q].x + v[q].y * v[q].y) + (v[q].z * v[q].z + v[q].w * v[q].w);
        const float rstd = 1.0f / sqrtf(wave_sum(s) * (1.0f / 1024.0f) + EPS);
#pragma unroll
        for (int q = 0; q < 4; ++q) { const int col = 8 * lane + 512 * (q >> 1) + 4 * (q & 1); *(f32x4*)(a->out + (size_t)row * D + col) = (v[q] * rstd) * ggv[q]; }
    }
}

__device__ __forceinline__ void kt_tile(KA a, int i, int tile, LAS unsigned char* lds, int tid_) {
    const int tid = mk_opaque_tid();
    const int ti = tile >> 4, ci = tile & 15, ta0 = ti * 128, col0 = ci * 128;
    LAS float* hT = (LAS float*)lds;
    LAS float* fw = (LAS float*)(lds + 34816);
    const float* hdn = (const float*)(a->ws + WS_HDN) + (size_t)i * NT_ALL * 64;
    const float* f3w = a->in[I_F3W] + (size_t)i * 64 * 2048;
    float* KT = (float*)(a->ws + WS_HB);
#pragma unroll
    for (int u = 0; u < 4; ++u) { const int idx = tid + NTHR * u, row = idx >> 4, k4 = idx & 15;
        const f32x4 v = *(const f32x4*)(hdn + (size_t)(ta0 + row) * 64 + 4 * k4);
        hT[(4 * k4 + 0) * 132 + row] = v.x; hT[(4 * k4 + 1) * 132 + row] = v.y; hT[(4 * k4 + 2) * 132 + row] = v.z; hT[(4 * k4 + 3) * 132 + row] = v.w;
        const int k = idx >> 5, c4 = idx & 31;
        *(LAS f32x4*)(fw + k * 128 + 4 * c4) = *(const f32x4*)(f3w + (size_t)k * 2048 + col0 + 4 * c4); }
    __syncthreads();
    const int tx = tid & 31, ty = tid >> 5;
    f32x4 acc[8];
#pragma unroll
    for (int cc = 0; cc < 8; ++cc) acc[cc] = (f32x4){0.f, 0.f, 0.f, 0.f};
#pragma unroll 4
    for (int k = 0; k < 64; ++k) {
        const f32x4 hv = *(const LAS f32x4*)(hT + k * 132 + 4 * tx);
        const f32x4 w0 = *(const LAS f32x4*)(fw + k * 128 + 8 * ty), w1 = *(const LAS f32x4*)(fw + k * 128 + 8 * ty + 4);
        acc[0] += w0.x * hv; acc[1] += w0.y * hv; acc[2] += w0.z * hv; acc[3] += w0.w * hv;
        acc[4] += w1.x * hv; acc[5] += w1.y * hv; acc[6] += w1.z * hv; acc[7] += w1.w * hv;
    }
#pragma unroll
    for (int cc = 0; cc < 8; ++cc) { const int col = col0 + 8 * ty + cc; const float bb = a->in[I_F3B][i * 2048 + col];
        *(f32x4*)(KT + (size_t)col * NT_ALL + ta0 + 4 * tx) = acc[cc] + bb; }
    __syncthreads();
}

template <bool INV> __device__ __forceinline__ f32x2 mul_w16(f32x2 v, int e) {
    float c, s;
    switch (e) { case 1: c = 0.92387953251f; s = 0.38268343237f; break; case 2: c = 0.70710678119f; s = 0.70710678119f; break; case 3: c = 0.38268343237f; s = 0.92387953251f; break;
                 case 6: c = -0.70710678119f; s = 0.70710678119f; break; case 9: c = -0.92387953251f; s = -0.38268343237f; break; default: c = 1.f; s = 0.f; break; }
    if (e == 0) return v;
    if (e == 4) return INV ? (f32x2){-v.y, v.x} : (f32x2){v.y, -v.x};
    return INV ? (f32x2){v.x * c - v.y * s, v.y * c + v.x * s} : (f32x2){v.x * c + v.y * s, v.y * c - v.x * s};
}
template <bool INV> __device__ __forceinline__ void dft4(f32x2& a, f32x2& b, f32x2& c, f32x2& d) {
    const f32x2 s0 = a + c, d0 = a - c, s1 = b + d, d1 = b - d;
    const f32x2 r = INV ? (f32x2){-d1.y, d1.x} : (f32x2){d1.y, -d1.x};
    a = s0 + s1; c = s0 - s1; b = d0 + r; d = d0 - r;
}
template <bool INV> __device__ __forceinline__ void dft16(f32x2 (&v)[16]) {
#pragma unroll
    for (int n2 = 0; n2 < 4; ++n2) dft4<INV>(v[n2], v[4 + n2], v[8 + n2], v[12 + n2]);
#pragma unroll
    for (int n2 = 1; n2 < 4; ++n2)
#pragma unroll
        for (int k1 = 1; k1 < 4; ++k1) v[4 * k1 + n2] = mul_w16<INV>(v[4 * k1 + n2], n2 * k1);
#pragma unroll
    for (int k1 = 0; k1 < 4; ++k1) dft4<INV>(v[4 * k1 + 0], v[4 * k1 + 1], v[4 * k1 + 2], v[4 * k1 + 3]);
#pragma unroll
    for (int x = 0; x < 4; ++x)
#pragma unroll
        for (int y = x + 1; y < 4; ++y) { const f32x2 t = v[4 * x + y]; v[4 * x + y] = v[4 * y + x]; v[4 * y + x] = t; }
}
__device__ __forceinline__ int fphys(int idx) { return idx + (idx >> 4); }
template <bool INV, int LGM, bool MUL = false, bool WAVE_LOCAL = false> __device__ __forceinline__ void r16_pass(LAS f32x2* buf, int tid_, const LAS f32x2* kbuf = nullptr, float kscale = 0.f) {
    const int tid = mk_opaque_tid();
    constexpr int LGS = LGM - 4, S = 1 << LGS, PST = S >= 16 ? S + S / 16 : 1;
    {
        const int half = tid >> 8, tp = tid & 255;
        const int blk = tp >> LGS, p = tp & (S - 1);
        const int base = (half << 12) + (blk << LGM) + p;
        LAS f32x2* bp = buf + fphys(base);
        const float angp = (float)p / (float)(1 << LGM);
        f32x2 v[16];
#pragma unroll
        for (int j = 0; j < 16; ++j) v[j] = bp[j * PST];
        if (INV && LGS > 0) {
            { const float c1 = __builtin_amdgcn_cosf(angp), s1 = __builtin_amdgcn_sinf(angp); float c = c1, s = s1;
#pragma unroll
              for (int r = 1; r < 16; ++r) { v[r] = (f32x2){v[r].x * c - v[r].y * s, v[r].y * c + v[r].x * s};
                  if ((r & 3) == 3) { const float an = angp * (float)(r + 1); c = __builtin_amdgcn_cosf(an); s = __builtin_amdgcn_sinf(an); } else { const float cn = c * c1 - s * s1; s = s * c1 + c * s1; c = cn; } } }
        }
        dft16<INV>(v);
        if (!INV && LGS > 0) {
            { const float c1 = __builtin_amdgcn_cosf(angp), s1 = __builtin_amdgcn_sinf(angp); float c = c1, s = s1;
#pragma unroll
              for (int r = 1; r < 16; ++r) { v[r] = (f32x2){v[r].x * c + v[r].y * s, v[r].y * c - v[r].x * s};
                  if ((r & 3) == 3) { const float an = angp * (float)(r + 1); c = __builtin_amdgcn_cosf(an); s = __builtin_amdgcn_sinf(an); } else { const float cn = c * c1 - s * s1; s = s * c1 + c * s1; c = cn; } } }
        }
        if (MUL) { const LAS f32x2* kp = kbuf + fphys(base);
#pragma unroll
            for (int j = 0; j < 16; ++j) { const f32x2 k = kp[j * PST], x = v[j]; v[j] = (f32x2){(x.x * k.x - x.y * k.y) * kscale, (x.x * k.y + x.y * k.x) * kscale}; } }
#pragma unroll
        for (int j = 0; j < 16; ++j) bp[j * PST] = v[j];
    }
    if (WAVE_LOCAL) asm volatile("s_waitcnt lgkmcnt(0)" ::: "memory"); else __syncthreads();
}
template <bool INV, bool MUL = false> __device__ __forceinline__ void fft8192(LAS f32x2* buf, int tid, const LAS f32x2* kbuf = nullptr, float kscale = 0.f) {
    if (!INV) { r16_pass<false, 12>(buf, tid); r16_pass<false, 8, false, true>(buf, tid); r16_pass<false, 4, MUL>(buf, tid, kbuf, kscale); }
    else { r16_pass<true, 4, false, true>(buf, tid); r16_pass<true, 8>(buf, tid); r16_pass<true, 12>(buf, tid); }
}
__device__ __forceinline__ float conv3(const bf16_t* z, int n, int L, float w0, float w1, float w2, float b) {
    float r = b + w1 * bf2f(z[n]);
    if (n > 0) r += w0 * bf2f(z[n - 1]);
    if (n < L - 1) r += w2 * bf2f(z[n + 1]);
    return r;
}
__device__ __forceinline__ void conv3x8(const bf16_t* z, int n0, int L, float w0, float w1, float w2, float b, float (&o)[8]) {
    const u32x4 w = *(const u32x4*)(z + n0);
    float x[10];
    x[0] = n0 > 0 ? bf2f(z[n0 - 1]) : 0.f; x[9] = n0 + 8 < L ? bf2f(z[n0 + 8]) : 0.f;
    x[1] = bflo(w.x); x[2] = bfhi(w.x); x[3] = bflo(w.y); x[4] = bfhi(w.y); x[5] = bflo(w.z); x[6] = bfhi(w.z); x[7] = bflo(w.w); x[8] = bfhi(w.w);
#pragma unroll
    for (int e = 0; e < 8; ++e) o[e] = b + w0 * x[e] + w1 * x[e + 1] + w2 * x[e + 2];
}
struct Raw8 { u32x4 w; unsigned l, r; };
__device__ __forceinline__ Raw8 raw8_load(const bf16_t* z, int n0, int L) { Raw8 q; q.w = *(const u32x4*)(z + n0); q.l = n0 > 0 ? (unsigned)z[n0 - 1] : 0u; q.r = n0 + 8 < L ? (unsigned)z[n0 + 8] : 0u; return q; }
__device__ __forceinline__ void conv3_raw(const Raw8& q, float w0, float w1, float w2, float b, float (&o)[8]) {
    float x[10];
    x[0] = bf2f(q.l); x[9] = bf2f(q.r);
    x[1] = bflo(q.w.x); x[2] = bfhi(q.w.x); x[3] = bflo(q.w.y); x[4] = bfhi(q.w.y); x[5] = bflo(q.w.z); x[6] = bfhi(q.w.z); x[7] = bflo(q.w.w); x[8] = bfhi(q.w.w);
#pragma unroll
    for (int e = 0; e < 8; ++e) o[e] = b + w0 * x[e] + w1 * x[e + 1] + w2 * x[e + 2];
}
constexpr int FBUF_BYTES = 8704 * 8;
__device__ __forceinline__ void hyena_item(KA a, int i, int c, LAS unsigned char* lds, int tid_, int lane_, int wave_) {
    const int tid = mk_opaque_tid(), lane = tid & 63, wave = __builtin_amdgcn_readfirstlane(tid >> 6);
    LAS f32x2* bufA = (LAS f32x2*)lds; LAS f32x2* bufB = (LAS f32x2*)(lds + FBUF_BYTES);
    LAS float* red = (LAS float*)(lds + 2 * FBUF_BYTES);
    const bf16_t* ZT = (const bf16_t*)(a->ws + WS_Z);
    float* YT = (float*)(a->ws + WS_H);
    bf16_t* MIX = (bf16_t*)(a->ws + WS_MIX);
    const float* KT = (const float*)(a->ws + WS_HB);
    const float* cw = a->in[I_HCW] + (size_t)i * 3 * 1536; const float* cb = a->in[I_HCB] + (size_t)i * 1536;
    const float la = -3.0701134573253945f, lb = -15.350567286626973f;
    const float delta = fabsf(la + (float)c * ((lb - la) / 511.0f));
    const float vw0 = cw[c], vw1 = cw[1536 + c], vw2 = cw[3072 + c], vb = cb[c];
#pragma unroll 1
    for (int o = 0; o < 2; ++o) {
        const float skip = a->in[I_SKIP][(i * 2 + o) * 512 + c];
        const int chg = (o + 1) * 512 + c;
        const float gw0 = cw[chg], gw1 = cw[1536 + chg], gw2 = cw[3072 + chg], gb = cb[chg];
        {
            int L = SEQ; asm volatile("" : "+s"(L));
            const int N = 2 * L, toff = 0, tokbase = 0;
            const int nact = L >> 3;
            const int n0 = tid * 8;
            const float invN = 1.0f / (float)N;
            float ssq = 0.f;
            if (tid < nact) {
                const float* k0p = KT + (size_t)((o * 2 + 0) * 512 + c) * NT_ALL + toff; const float* k1p = KT + (size_t)((o * 2 + 1) * 512 + c) * NT_ALL + toff;
                const float tscale = delta / (float)(L - 1);
                const f32x4 h0 = *(const f32x4*)(k0p + n0), h1 = *(const f32x4*)(k0p + n0 + 4);
                const float hh0[8] = {h0.x, h0.y, h0.z, h0.w, h1.x, h1.y, h1.z, h1.w};
#pragma unroll
                for (int e = 0; e < 8; ++e) { const int n = n0 + e;
                    const float ka = hh0[e] * __expf(-(float)n * tscale);
                    const float kb = n > 0 ? k1p[L - n] * __expf(-(float)(L - n) * tscale) : 0.f;
                    ssq += ka * ka + kb * kb;
                    const float ang = (float)n * invN, cs = __builtin_amdgcn_cosf(ang), sn = __builtin_amdgcn_sinf(ang), df = ka - kb;
                    bufA[fphys(n)] = (f32x2){ka + kb, 0.f};
                    bufA[fphys(n + L)] = (f32x2){df * cs, -df * sn}; }
            }
            ssq = wave_sum(ssq);
            if (lane == 0) red[wave] = ssq;
            __syncthreads();
            float tot = 0.f;
#pragma unroll
            for (int w = 0; w < NWAVES; ++w) tot += red[w];
            const float scale = (1.0f / sqrtf(tot + EPS)) * invN;
            fft8192<false>(bufA, tid);
#pragma unroll 1
            for (int pair = 0; pair < 2; ++pair) {
                const int tok0 = tokbase + (2 * pair) * L, tok1 = tok0 + L;
                const bf16_t* zv0 = ZT + (size_t)c * MT + tok0; const bf16_t* zv1 = ZT + (size_t)c * MT + tok1;
                const bf16_t* zg0 = ZT + (size_t)chg * MT + tok0; const bf16_t* zg1 = ZT + (size_t)chg * MT + tok1;
                float* y0p = YT + (size_t)c * MT + tok0; float* y1p = YT + (size_t)c * MT + tok1;
                float x0[8], x1[8]; Raw8 gq0, gq1;
                if (tid < nact) {
                    if (o == 0) { conv3x8(zv0, n0, L, vw0, vw1, vw2, vb, x0); conv3x8(zv1, n0, L, vw0, vw1, vw2, vb, x1); }
                    else { const f32x4 a0 = *(const f32x4*)(y0p + n0), a1 = *(const f32x4*)(y0p + n0 + 4), b0 = *(const f32x4*)(y1p + n0), b1 = *(const f32x4*)(y1p + n0 + 4);
                        x0[0] = a0.x; x0[1] = a0.y; x0[2] = a0.z; x0[3] = a0.w; x0[4] = a1.x; x0[5] = a1.y; x0[6] = a1.z; x0[7] = a1.w;
                        x1[0] = b0.x; x1[1] = b0.y; x1[2] = b0.z; x1[3] = b0.w; x1[4] = b1.x; x1[5] = b1.y; x1[6] = b1.z; x1[7] = b1.w; }
#pragma unroll
                    for (int e = 0; e < 8; ++e) { const int n = n0 + e; const float ang = (float)n * invN, cs = __builtin_amdgcn_cosf(ang), sn = __builtin_amdgcn_sinf(ang);
                        bufB[fphys(n)] = (f32x2){x0[e], x1[e]};
                        bufB[fphys(n + L)] = (f32x2){x0[e] * cs + x1[e] * sn, x1[e] * cs - x0[e] * sn}; }
                    gq0 = raw8_load(zg0, n0, L); gq1 = raw8_load(zg1, n0, L);
                }
                __syncthreads();
                fft8192<false, true>(bufB, tid, bufA, scale);
                fft8192<true>(bufB, tid);
                if (tid < nact) {
                    float g0[8], g1[8], lc0[8], lc1[8];
                    conv3_raw(gq0, gw0, gw1, gw2, gb, g0); conv3_raw(gq1, gw0, gw1, gw2, gb, g1);
#pragma unroll
                    for (int e = 0; e < 8; ++e) { const int n = n0 + e; const float ang = (float)n * invN, cs = __builtin_amdgcn_cosf(ang), sn = __builtin_amdgcn_sinf(ang);
                        const f32x2 u = bufB[fphys(n)], v = bufB[fphys(n + L)];
                        lc0[e] = u.x + (v.x * cs - v.y * sn); lc1[e] = u.y + (v.y * cs + v.x * sn); }
                    if (o == 0) {
                        const float (&v0)[8] = x0; const float (&v1)[8] = x1;
                        f32x4 r0, r1, s0, s1;
                        r0.x = g0[0] * (lc0[0] + skip * v0[0]); r0.y = g0[1] * (lc0[1] + skip * v0[1]); r0.z = g0[2] * (lc0[2] + skip * v0[2]); r0.w = g0[3] * (lc0[3] + skip * v0[3]);
                        r1.x = g0[4] * (lc0[4] + skip * v0[4]); r1.y = g0[5] * (lc0[5] + skip * v0[5]); r1.z = g0[6] * (lc0[6] + skip * v0[6]); r1.w = g0[7] * (lc0[7] + skip * v0[7]);
                        s0.x = g1[0] * (lc1[0] + skip * v1[0]); s0.y = g1[1] * (lc1[1] + skip * v1[1]); s0.z = g1[2] * (lc1[2] + skip * v1[2]); s0.w = g1[3] * (lc1[3] + skip * v1[3]);
                        s1.x = g1[4] * (lc1[4] + skip * v1[4]); s1.y = g1[5] * (lc1[5] + skip * v1[5]); s1.z = g1[6] * (lc1[6] + skip * v1[6]); s1.w = g1[7] * (lc1[7] + skip * v1[7]);
                        *(f32x4*)(y0p + n0) = r0; *(f32x4*)(y0p + n0 + 4) = r1; *(f32x4*)(y1p + n0) = s0; *(f32x4*)(y1p + n0 + 4) = s1;
                    } else {
                        const float (&v0)[8] = x0; const float (&v1)[8] = x1;
#pragma unroll
                        for (int e = 0; e < 8; ++e) {
                            MIX[(size_t)(tok0 + n0 + e) * D + c] = (bf16_t)f2bf(g0[e] * (lc0[e] + skip * v0[e]));
                            MIX[(size_t)(tok1 + n0 + e) * D + c] = (bf16_t)f2bf(g1[e] * (lc1[e] + skip * v1[e])); }
                    }
                }
                __syncthreads();
            }
        }
    }
    {
        LAS float* kf = (LAS float*)lds;
        LAS float* vbuf = (LAS float*)(lds + 4096);
        LAS float* ybuf = (LAS float*)(lds + 8192);
        const int t = tid & 255, bp = tid >> 8;
#pragma unroll 1
        for (int o = 0; o < 2; ++o) {
            const float skip = a->in[I_SKIP][(i * 2 + o) * 512 + c];
            const int chg = (o + 1) * 512 + c;
            const float gw0 = cw[chg], gw1 = cw[1536 + chg], gw2 = cw[3072 + chg], gb = cb[chg];
            float ssq = 0.f;
            if (tid < 256) {
                const float tscale = delta / (float)(CTXL - 1);
                const float dec = __expf(-(float)tid * tscale);
                const float k0 = KT[(size_t)((o * 2 + 0) * 512 + c) * NT_ALL + SEQ + tid] * dec;
                kf[255 + tid] = k0; ssq = k0 * k0;
                if (tid > 0) { const float k1 = KT[(size_t)((o * 2 + 1) * 512 + c) * NT_ALL + SEQ + tid] * dec; kf[255 - tid] = k1; ssq += k1 * k1; }
            }
            for (int e = tid; e < 1024; e += NTHR) { const int bb = e >> 8, tt = e & 255;
                if (o == 0) vbuf[e] = conv3(ZT + (size_t)c * MT + ML + bb * CTXL, tt, CTXL, vw0, vw1, vw2, vb); else vbuf[e] = ybuf[e]; }
            ssq = wave_sum(ssq);
            if (lane == 0) red[wave] = ssq;
            __syncthreads();
            float tot = 0.f;
#pragma unroll
            for (int w = 0; w < NWAVES; ++w) tot += red[w];
            const float scale = 1.0f / sqrtf(tot + EPS);
            float a0 = 0.f, a1 = 0.f;
            const LAS float* v0p = vbuf + (2 * bp) * 256; const LAS float* v1p = v0p + 256; const LAS float* kp = kf + 255 + t;
#pragma unroll 8
            for (int s = 0; s < 256; ++s) { const float kk = kp[-s]; a0 += kk * v0p[s]; a1 += kk * v1p[s]; }
            const int b0 = 2 * bp, b1 = b0 + 1;
            const float g0 = conv3(ZT + (size_t)chg * MT + ML + b0 * CTXL, t, CTXL, gw0, gw1, gw2, gb), g1 = conv3(ZT + (size_t)chg * MT + ML + b1 * CTXL, t, CTXL, gw0, gw1, gw2, gb);
            const float r0 = g0 * (a0 * scale + skip * v0p[t]), r1 = g1 * (a1 * scale + skip * v1p[t]);
            __syncthreads();
            if (o == 0) { ybuf[b0 * 256 + t] = r0; ybuf[b1 * 256 + t] = r1; }
            else { MIX[(size_t)(ML + b0 * CTXL + t) * D + c] = (bf16_t)f2bf(r0); MIX[(size_t)(ML + b1 * CTXL + t) * D + c] = (bf16_t)f2bf(r1); }
            __syncthreads();
        }
    }
}
__device__ __forceinline__ void sgu_item(KA a, int i, int item, LAS unsigned char* lds, int tid_) {
    const int tid = mk_opaque_tid();
    const int chunk = item >> 2, g = item & 3, tok0 = chunk * 128;
    const bf16_t* ZB = (const bf16_t*)(a->ws + WS_Z) + (size_t)1536 * MT;
    bf16_t* MIX = (bf16_t*)(a->ws + WS_MIX);
    LAS float* Wl = (LAS float*)lds; LAS float* Vl = (LAS float*)(lds + 65536); LAS float* st = (LAS float*)(lds + 131072);
    const float* Wg = a->in[I_SGUW] + (size_t)(i * 4 + g) * 16384;
    f32x4 wraw[4][2]; u32x4 vraw[4];
#pragma unroll
    for (int u = 0; u < 4; ++u) { const int idx = tid + NTHR * u, p = idx >> 4, q0 = (idx & 15) * 8;
        wraw[u][0] = *(const f32x4*)(Wg + p * 128 + q0); wraw[u][1] = *(const f32x4*)(Wg + p * 128 + q0 + 4);
        vraw[u] = *(const u32x4*)(ZB + (size_t)(tok0 + p) * D + 512 + g * 128 + q0); }
    {
        const int t = tid >> 2, part = tid & 3; const bf16_t* p = ZB + (size_t)(tok0 + t) * D + 512 + part * 128;
        float s = 0.f, ss = 0.f;
#pragma unroll
        for (int v = 0; v < 16; ++v) { const u32x4 w = *(const u32x4*)(p + 8 * v);
#pragma unroll
            for (int j = 0; j < 4; ++j) { const float x0 = bflo(w[j]), x1 = bfhi(w[j]); s += x0 + x1; ss += x0 * x0 + x1 * x1; } }
        s += __shfl_xor(s, 1); s += __shfl_xor(s, 2); ss += __shfl_xor(ss, 1); ss += __shfl_xor(ss, 2);
        const float mean = s * (1.0f / 512.0f), var = fmaxf(ss * (1.0f / 512.0f) - mean * mean, 0.f);
        if (part == 0) { st[t] = mean; st[128 + t] = 1.0f / sqrtf(var + EPS); }
    }
    LAS bf16_t* Wb = (LAS bf16_t*)lds; LAS bf16_t* VT = (LAS bf16_t*)(lds + 34816);
#pragma unroll
    for (int u = 0; u < 4; ++u) { const int idx = tid + NTHR * u, p = idx >> 4, q0 = (idx & 15) * 8;
        const f32x4 w0 = wraw[u][0], w1 = wraw[u][1];
        u32x4 pk; pk.x = pk2(w0.x, w0.y); pk.y = pk2(w0.z, w0.w); pk.z = pk2(w1.x, w1.y); pk.w = pk2(w1.z, w1.w);
        *(LAS u32x4*)(Wb + p * 136 + q0) = pk; }
    __syncthreads();
    const float* lng = a->in[I_LNG] + i * 512 + g * 128;
#pragma unroll
    for (int u = 0; u < 4; ++u) { const int vv = tid + NTHR * u, q = vv >> 4, d0 = (vv & 15) * 8;
        const u32x4 w = vraw[u];
        const float m = st[q], r = st[128 + q];
        const f32x4 l0 = *(const f32x4*)(lng + d0), l1 = *(const f32x4*)(lng + d0 + 4);
        float o[8];
        o[0] = (bflo(w.x) - m) * r * l0.x; o[1] = (bfhi(w.x) - m) * r * l0.y; o[2] = (bflo(w.y) - m) * r * l0.z; o[3] = (bfhi(w.y) - m) * r * l0.w;
        o[4] = (bflo(w.z) - m) * r * l1.x; o[5] = (bfhi(w.z) - m) * r * l1.y; o[6] = (bflo(w.w) - m) * r * l1.z; o[7] = (bfhi(w.w) - m) * r * l1.w;
#pragma unroll
        for (int j = 0; j < 8; ++j) VT[(d0 + j) * 136 + q] = (bf16_t)f2bf(o[j]); }
    __syncthreads();
    {
        const int lane = tid & 63, wv = tid >> 6, tk = lane & 15, kq = lane >> 4;
        bf16x8 af[4];
#pragma unroll
        for (int ks = 0; ks < 4; ++ks) af[ks] = *(const LAS bf16x8*)(VT + (16 * wv + tk) * 136 + 32 * ks + 8 * kq);
#pragma unroll 2
        for (int nt = 0; nt < 8; ++nt) {
            f32x4 acc = (f32x4){0.f, 0.f, 0.f, 0.f};
#pragma unroll
            for (int ks = 0; ks < 4; ++ks) { const bf16x8 bfr = *(const LAS bf16x8*)(Wb + (16 * nt + tk) * 136 + 32 * ks + 8 * kq); acc = __builtin_amdgcn_mfma_f32_16x16x32_bf16(af[ks], bfr, acc, 0, 0, 0); }
            const int p = 16 * nt + tk, tok = tok0 + p, d0 = 16 * wv + 4 * kq;
            const float bias = a->in[I_SGUB][(i * 4 + g) * 128 + p];
            const u32x2 uw = *(const u32x2*)(ZB + (size_t)tok * D + g * 128 + d0);
            u32x2 w; w.x = pk2(bflo(uw.x) * (acc.x + bias), bfhi(uw.x) * (acc.y + bias)); w.y = pk2(bflo(uw.y) * (acc.z + bias), bfhi(uw.y) * (acc.w + bias));
            *(u32x2*)(MIX + (size_t)tok * D + 512 + g * 128 + d0) = w;
        }
    }
    __syncthreads();
}

template <int S> __device__ __forceinline__ float dpp_row_shr(float v, float ident) {
    return __builtin_bit_cast(float, __builtin_amdgcn_update_dpp(__builtin_bit_cast(int, ident), __builtin_bit_cast(int, v), 0x110 + S, 0xf, 0xf, false));
}
__device__ __forceinline__ int rg_pos(int S, int wave, int tk, int dir, int& Lq) {
    const bool isctx = S < 2; const int sl = (isctx ? 0 : (S >> 1) - 1) * 256 + wave * 32 + (S & 1) * 16 + tk; Lq = isctx ? CTXL : SEQ; return dir ? (Lq - 1 - sl) : sl;
}
__device__ __forceinline__ int rg_row(int S, int b, int pp, bool colmajor) { return S < 2 ? (ML + b * CTXL + pp) : (b * SEQ + (colmajor ? (((pp & 63) << 6) + (pp >> 6)) : pp)); }
__device__ __forceinline__ void rg_issue(const bf16_t* Zx, int S, int wave, int tk, int kq, int dir, int b, bool colmajor, u32x4 (&pre)[12]) {
    int Lq; const int p = rg_pos(S, wave, tk, dir, Lq);
#pragma unroll
    for (int k = 0; k < 4; ++k) { int pp = p + k - 2; pp = pp < 0 ? 0 : (pp > Lq - 1 ? Lq - 1 : pp);
        const bf16_t* rp = Zx + (size_t)rg_row(S, b, pp, colmajor) * NOIN;
#pragma unroll
        for (int ks = 0; ks < 3; ++ks) { int d0 = 32 * ks + 8 * kq; d0 = d0 > 80 ? 80 : d0; pre[k * 3 + ks] = *(const u32x4*)(rp + d0); } }
}
__device__ __forceinline__ void rglru_item(KA a, int i, bool colmajor, int item, LAS unsigned char* lds) {
    const int tid = mk_opaque_tid(), lane = tid & 63, wave = __builtin_amdgcn_readfirstlane(tid >> 6);
    const int half = item & 1, dir = (item >> 1) & 1, hh = (item >> 2) & 15, b = item >> 6;
    const int ebase = half ? 40 : 0;
    LAS unsigned char* WAl = lds; LAS unsigned char* WXl = lds + 18432;
    LAS float* tab = (LAS float*)(lds + 36864);
    LAS float* xsw = (LAS float*)(lds + 40960) + wave * 1600;
    LAS float* agg = (LAS float*)(lds + 92160);
    LAS int* flg = (LAS int*)(lds + 92160 + 8192);
    LAS float* t0a = (LAS float*)(lds + 92160 + 8192 + 256) + wave * 192;
    const bf16_t* Zx = (const bf16_t*)(a->ws + WS_Z) + DRNN + hh * 88;
    bf16_t* HO = (bf16_t*)(a->ws + (dir ? WS_HB : WS_MIX));
    u32x4 pre[12];
    if (RG_PREFETCH) rg_issue(Zx, 0, wave, lane & 15, lane >> 4, dir, b, colmajor, pre);
    {
        const u32x4* src = (const u32x4*)((const bf16_t*)(a->ws + WS_RGW) + (size_t)(((i * 2 + dir) * 2 + 0) * 16 + hh) * 9216);
        const u32x4* srx = (const u32x4*)((const bf16_t*)(a->ws + WS_RGW) + (size_t)(((i * 2 + dir) * 2 + 1) * 16 + hh) * 9216);
        for (int v = tid; v < 1152; v += NTHR) { *(LAS u32x4*)(WAl + 16 * v) = src[v]; *(LAS u32x4*)(WXl + 16 * v) = srx[v]; }
        if (tid < 96) { const int e = tid, ch = hh * 88 + (e < 88 ? e : 87); const int pd = (i * 2 + dir) * DRNN + ch;
#pragma unroll
            for (int k = 0; k < 4; ++k) tab[k * 96 + e] = a->in[I_RCW][(size_t)(i * 4 + k) * DRNN + ch];
            tab[384 + e] = a->in[I_RCB][i * DRNN + ch]; tab[480 + e] = a->in[I_RBA][pd]; tab[576 + e] = a->in[I_RBX][pd];
            tab[672 + e] = -8.0f * 1.4426950408889634f * log1pf(expf(-a->in[I_LAM][pd])); }
        if (tid < 8) flg[tid] = 0;
    }
    __syncthreads();
    const int tk = lane & 15, kq = lane >> 4;
    bf16x8 FA[3][3], FX[3][3];
#pragma unroll
    for (int mt = 0; mt < 3; ++mt)
#pragma unroll
        for (int ks = 0; ks < 3; ++ks) { FA[mt][ks] = *(const LAS bf16x8*)(WAl + (ebase + 16 * mt + tk) * 192 + (32 * ks + 8 * kq) * 2); FX[mt][ks] = *(const LAS bf16x8*)(WXl + (ebase + 16 * mt + tk) * 192 + (32 * ks + 8 * kq) * 2); }
    f32x4 Ac0[3], Bc0[3]; int p_t0 = 0;
#pragma unroll
    for (int mt = 0; mt < 3; ++mt) { Ac0[mt] = (f32x4){0.f, 0.f, 0.f, 0.f}; Bc0[mt] = Ac0[mt]; }
#pragma unroll 1
    for (int S = 0; S < 34; ++S) {
        int Lq; const int p = rg_pos(S, wave, tk, dir, Lq);
        if (!RG_PREFETCH) rg_issue(Zx, S, wave, tk, kq, dir, b, colmajor, pre);
        bf16x8 Bf[3];
#pragma unroll
        for (int ks = 0; ks < 3; ++ks) {
            const int d0 = 32 * ks + 8 * kq;
            if (d0 < 88) {
                f32x4 x0 = *(const LAS f32x4*)(tab + 384 + d0), x1 = *(const LAS f32x4*)(tab + 384 + d0 + 4);
#pragma unroll
                for (int k = 0; k < 4; ++k) { const int pp = p + k - 2;
                    if (pp >= 0 && pp < Lq) {
                        const u32x4 w = pre[k * 3 + ks];
                        const f32x4 c0 = *(const LAS f32x4*)(tab + k * 96 + d0), c1 = *(const LAS f32x4*)(tab + k * 96 + d0 + 4);
                        x0.x += c0.x * bflo(w.x); x0.y += c0.y * bfhi(w.x); x0.z += c0.z * bflo(w.y); x0.w += c0.w * bfhi(w.y);
                        x1.x += c1.x * bflo(w.z); x1.y += c1.y * bfhi(w.z); x1.z += c1.z * bflo(w.w); x1.w += c1.w * bfhi(w.w); } }
                *(LAS f32x4*)(xsw + tk * 100 + d0) = x0; *(LAS f32x4*)(xsw + tk * 100 + d0 + 4) = x1;
                u32x4 pk; pk.x = pk2(x0.x, x0.y); pk.y = pk2(x0.z, x0.w); pk.z = pk2(x1.x, x1.y); pk.w = pk2(x1.z, x1.w);
                Bf[ks] = __builtin_bit_cast(bf16x8, pk);
            } else Bf[ks] = (bf16x8){0, 0, 0, 0, 0, 0, 0, 0};
        }
        if (RG_PREFETCH && S + 1 < 34) rg_issue(Zx, S + 1, wave, tk, kq, dir, b, colmajor, pre);
        asm volatile("s_waitcnt lgkmcnt(0)" ::: "memory");
        f32x4 Ac[3], Bc[3];
#pragma unroll
        for (int mt = 0; mt < 3; ++mt) {
            const int e0 = ebase + 16 * mt;
            f32x4 ca = (f32x4){0.f, 0.f, 0.f, 0.f}, cx = ca;
#pragma unroll
            for (int ks = 0; ks < 3; ++ks) {
                ca = __builtin_amdgcn_mfma_f32_16x16x32_bf16(FA[mt][ks], Bf[ks], ca, 0, 0, 0);
                cx = __builtin_amdgcn_mfma_f32_16x16x32_bf16(FX[mt][ks], Bf[ks], cx, 0, 0, 0);
            }
            const int eb = e0 + 4 * kq;
            const f32x4 ba4 = *(const LAS f32x4*)(tab + 480 + eb), bx4 = *(const LAS f32x4*)(tab + 576 + eb), sp4 = *(const LAS f32x4*)(tab + 672 + eb);
            const f32x4 xe = *(const LAS f32x4*)(xsw + tk * 100 + eb);
            f32x4 Aj, Bj;
#pragma unroll
            for (int j = 0; j < 4; ++j) {
                const float r = sigmoidf_(ca[j] + ba4[j]), gi = sigmoidf_(cx[j] + bx4[j]);
                const float av = __builtin_amdgcn_exp2f(r * sp4[j]);
                Aj[j] = av; Bj[j] = __builtin_amdgcn_sqrtf(fmaxf(1.0f - av * av, 0.f)) * gi * xe[j];
            }
            {
                float a0 = Aj[0], a1 = Aj[1], a2 = Aj[2], a3 = Aj[3], b0 = Bj[0], b1 = Bj[1], b2 = Bj[2], b3 = Bj[3];
#define RG_STEP(SH) asm volatile("s_nop 1\n\t" \
                "v_fmac_f32_dpp %0, %0, %4 row_shr:" #SH " row_mask:0xf bank_mask:0xf\n\tv_mul_f32_dpp %4, %4, %4 row_shr:" #SH " row_mask:0xf bank_mask:0xf\n\t" \
                "v_fmac_f32_dpp %1, %1, %5 row_shr:" #SH " row_mask:0xf bank_mask:0xf\n\tv_mul_f32_dpp %5, %5, %5 row_shr:" #SH " row_mask:0xf bank_mask:0xf\n\t" \
                "v_fmac_f32_dpp %2, %2, %6 row_shr:" #SH " row_mask:0xf bank_mask:0xf\n\tv_mul_f32_dpp %6, %6, %6 row_shr:" #SH " row_mask:0xf bank_mask:0xf\n\t" \
                "v_fmac_f32_dpp %3, %3, %7 row_shr:" #SH " row_mask:0xf bank_mask:0xf\n\tv_mul_f32_dpp %7, %7, %7 row_shr:" #SH " row_mask:0xf bank_mask:0xf\n\ts_nop 1" \
                : "+v"(b0), "+v"(b1), "+v"(b2), "+v"(b3), "+v"(a0), "+v"(a1), "+v"(a2), "+v"(a3));
                RG_STEP(1) RG_STEP(2) RG_STEP(4) RG_STEP(8)
                Aj = (f32x4){a0, a1, a2, a3}; Bj = (f32x4){b0, b1, b2, b3};
            }
#undef RG_STEP
            Ac[mt] = Aj; Bc[mt] = Bj;
        }
        if ((S & 1) == 0) {
#pragma unroll
            for (int mt = 0; mt < 3; ++mt) { Ac0[mt] = Ac[mt]; Bc0[mt] = Bc[mt]; }
            p_t0 = p;
            if (tk == 15) {
#pragma unroll
                for (int mt = 0; mt < 3; ++mt) { *(LAS f32x4*)(t0a + ebase + 16 * mt + 4 * kq) = Ac[mt]; *(LAS f32x4*)(t0a + 96 + ebase + 16 * mt + 4 * kq) = Bc[mt]; }
            }
        } else {
            const int SS = S >> 1;
            f32x4 cin[3], cin1[3];
            const int pw = wave == 0 ? 7 : wave - 1, need = wave == 0 ? SS : SS + 1, par = (wave == 0 ? SS + 1 : SS) & 1;
            asm volatile("s_waitcnt lgkmcnt(0)" ::: "memory");
            if (need > 0) {
                while (*(volatile LAS int*)(flg + pw) < need) __builtin_amdgcn_s_sleep(0);
                asm volatile("" ::: "memory");
#pragma unroll
                for (int mt = 0; mt < 3; ++mt) cin[mt] = *(const LAS f32x4*)(agg + par * 768 + pw * 96 + ebase + 16 * mt + 4 * kq);
            } else {
#pragma unroll
                for (int mt = 0; mt < 3; ++mt) cin[mt] = (f32x4){0.f, 0.f, 0.f, 0.f};
            }
#pragma unroll
            for (int mt = 0; mt < 3; ++mt) { const f32x4 a0 = *(const LAS f32x4*)(t0a + ebase + 16 * mt + 4 * kq), b0 = *(const LAS f32x4*)(t0a + 96 + ebase + 16 * mt + 4 * kq); cin1[mt] = a0 * cin[mt] + b0; }
            if (tk == 15) {
#pragma unroll
                for (int mt = 0; mt < 3; ++mt) *(LAS f32x4*)(agg + (SS & 1) * 768 + wave * 96 + ebase + 16 * mt + 4 * kq) = Ac[mt] * cin1[mt] + Bc[mt];
            }
            asm volatile("s_waitcnt lgkmcnt(0)" ::: "memory");
            if (lane == 0) *(volatile LAS int*)(flg + wave) = SS + 1;
            {
                const int row0 = rg_row(S, b, p_t0, colmajor), row1 = rg_row(S, b, p, colmajor);
#pragma unroll
                for (int mt = 0; mt < 3; ++mt) { const int eb = ebase + 16 * mt + 4 * kq;
                    const f32x4 h0 = Bc0[mt] + Ac0[mt] * cin[mt], h1 = Bc[mt] + Ac[mt] * cin1[mt];
                    u32x2 w0; w0.x = pk2(h0.x, h0.y); w0.y = pk2(h0.z, h0.w);
                    u32x2 w1; w1.x = pk2(h1.x, h1.y); w1.y = pk2(h1.z, h1.w);
                    *(u32x2*)(HO + (size_t)row0 * DRNN + hh * 88 + eb) = w0;
                    *(u32x2*)(HO + (size_t)row1 * DRNN + hh * 88 + eb) = w1; }
            }
        }
    }
    __syncthreads();
}
__device__ __forceinline__ void phase_rg_combine(KA a, size_t gt, size_t GT) {
    const bf16_t* Z = (const bf16_t*)(a->ws + WS_Z); bf16_t* MIX = (bf16_t*)(a->ws + WS_MIX); const bf16_t* HB = (const bf16_t*)(a->ws + WS_HB);
    const size_t total = (size_t)MT * 176;
    for (size_t idx0 = gt; idx0 < total; idx0 += 4 * GT) {
        u32x4 g[4], hf[4], hb[4]; size_t off[4]; bool ok[4];
#pragma unroll
        for (int u = 0; u < 4; ++u) { const size_t idx = idx0 + u * GT; ok[u] = idx < total; const size_t ic = ok[u] ? idx : gt; const size_t row = ic / 176; const int v = (int)(ic % 176);
            off[u] = row * DRNN + 8 * v; g[u] = *(const u32x4*)(Z + row * NOIN + 8 * v); hf[u] = *(const u32x4*)(MIX + off[u]); hb[u] = *(const u32x4*)(HB + off[u]); }
#pragma unroll
        for (int u = 0; u < 4; ++u) { u32x4 o;
#pragma unroll
            for (int j = 0; j < 4; ++j) { const float s0 = bflo(hf[u][j]) + bflo(hb[u][j]), s1 = bfhi(hf[u][j]) + bfhi(hb[u][j]); o[j] = pk2(bflo(g[u][j]) * s0, bfhi(g[u][j]) * s1); }
            if (ok[u]) *(u32x4*)(MIX + off[u]) = o; }
    }
}

__global__ void __launch_bounds__(NTHR, 2) mk_fwd(Args a_unused) {
    KA a = (KA)__builtin_amdgcn_kernarg_segment_ptr();
    extern __shared__ __attribute__((aligned(16))) unsigned char lds_raw[];
    LAS unsigned char* lds = (LAS unsigned char*)lds_raw;
    const int G = gridDim.x, bid = blockIdx.x;
    volatile LAS unsigned* bst = (volatile LAS unsigned*)(lds + LDS_BYTES - 64);
    if (threadIdx.x < 2) bst[threadIdx.x] = 0u;
    __syncthreads();
    XcdBarrier bar = xcd_barrier_post((unsigned*)(a->ws + WS_BAR), bst);
#define GRID_SYNC() do { if (USE_XCD_BAR) xcd_barrier(bar); else cg::this_grid().sync(); } while (0)
    for (int ph = a->ph_lo; ph < a->ph_hi; ++ph) {
        if (ph >= 1 && ph <= 32 && ((ph - 1) & 7) == 3 && !(((ph - 1) >> 3) & 1)) continue;
        int nrep = 1;
#if PROBE_REP == 1
        if (ph >= 1 && ph <= 32 && ((ph - 1) & 7) == 2 && !(((ph - 1) >> 3) & 1)) nrep = 2;
#elif PROBE_REP == 2
        if (ph >= 1 && ph <= 32 && ((ph - 1) & 7) == 2 && (((ph - 1) >> 3) & 1)) nrep = 2;
#elif PROBE_REP == 3
        if (ph == 0) nrep = 2;
#elif PROBE_REP == 4
        if (ph >= 1 && ph <= 32 && (((ph - 1) & 7) == 0 || ((ph - 1) & 7) == 5)) nrep = 2;
#elif PROBE_REP == 6
        if (ph >= 1 && ph <= 32 && ((ph - 1) & 7) == 6) nrep = 2;
#elif PROBE_REP == 7
        if (ph >= 1 && ph <= 32 && ((ph - 1) & 7) == 1) nrep = 2;
#endif
        for (int rep = 0; rep < nrep; ++rep) {
        if (rep) GRID_SYNC();
        const int tid = mk_opaque_tid(), lane = tid & 63, wave = __builtin_amdgcn_readfirstlane(tid >> 6);
        const int gw = bid * NWAVES + wave, NGW = G * NWAVES;
        const size_t gt = (size_t)bid * NTHR + tid, GT = (size_t)G * NTHR;
        asm volatile("" : "+s"(a));
        unsigned char* ws = a->ws;
        if (ph == 0) phase0(a, lds, tid, lane, wave, bid, G);
        else if (ph == 33) phase_final(a, lane, gw, NGW);
        else {
            const int l = (ph - 1) >> 3, k = (ph - 1) & 7, i = l >> 1; const bool odd = l & 1;
            const float* modl = (const float*)(ws + WS_MOD) + (size_t)l * 5 * NMOD;
            if (k == 0) { phase_norm(a, l, 0, a->in[I_GMIX] + l * D, lane, gw, NGW, l > 0 ? DFF / 256 : 0, modl - 5 * NMOD + 5 * 1024); if (!odd) { for (int tile = bid; tile < 544; tile += G) kt_tile(a, i, tile, lds, tid); } }
            else if (k == 5) phase_norm(a, l, 3, a->in[I_GFFN] + l * D, lane, gw, NGW, l < DEPTH - 1 ? (odd ? DRNN / 128 : D / 128) : 0, modl + 2 * 1024);
            else if (k == 1) {
                if (odd) {
                    pg8::Gemm g{(const bf16_t*)(ws + WS_H), (const bf16_t*)(ws + W_OIN(i)), MT, NOIN, D, D};
                    EpiStore E{(bf16_t*)(ws + WS_Z), NOIN, 11, nullptr, 0};
                    pg8::StaticOrder S; S.init(g.M, g.N, G, bid);
                    pg8::gemm_phase<EpiStore, pg8::StaticOrder, MK_ALIGN, MK_SP2>(lds, g, S, E);
                } else {
                    pg8::Gemm g{(const bf16_t*)(ws + WS_H), (const bf16_t*)(ws + W_EIN(i)), MT, NEIN, D, D};
                    EpiStore E{(bf16_t*)(ws + WS_Z) + (size_t)1536 * MT - 1536, D, 1 << 20, (bf16_t*)(ws + WS_Z), MT};
                    pg8::MergedOrder S; S.init(G, bid);
                    pg8::gemm_phase<EpiStore, pg8::MergedOrder, MK_ALIGN, MK_SP2>(lds, g, S, E);
                }
            }
            else if (k == 2) {
                if (!odd) { for (int it = bid; it < 512 + 544; it += G) { const int nr = (PROBE_REP == 8 && it >= 512) || (PROBE_REP == 9 && it < 512) ? 2 : 1; for (int rr = 0; rr < nr; ++rr) { if (it < 512) hyena_item(a, i, it, lds, tid, lane, wave); else { const int s = it - 512, v = s & 255; sgu_item(a, i, (G == 256 && s < 512) ? ((s & ~255) + ((v & 7) * 8 + (v >> 5)) * 4 + ((v >> 3) & 3)) : s, lds, tid); } }     } }
                else { for (int it = bid; it < 256; it += G) rglru_item(a, i, (i & 1) == 1, G == 256 ? (((it & 7) * 8 + (it >> 5)) * 4 + ((it >> 3) & 3)) : it, lds); }
            }
            else if (k == 3) { if (odd) phase_rg_combine(a, gt, GT); }
            else if (k == 4 || k == 7) {
                const bf16_t* Ap; const bf16_t* Bp; int Kf;
                if (k == 7) { Ap = (const bf16_t*)(ws + WS_Z); Bp = (const bf16_t*)(ws + W_FFNOUT(l)); Kf = DFF; }
                else if (odd) { Ap = (const bf16_t*)(ws + WS_MIX); Bp = (const bf16_t*)(ws + W_OOUT(i)); Kf = DRNN; }
                else { Ap = (const bf16_t*)(ws + WS_MIX); Bp = (const bf16_t*)(ws + W_EOUT(i)); Kf = D; }
                const float* modp = modl + (k == 7 ? 5 : 2) * 1024;
                {
                    pg8::Gemm g{Ap, Bp, ML, D, Kf, Kf};
                    EpiRes E{modp, (bf16_t*)(ws + WS_XS16), (l == 0 && k == 4) ? a->in[I_X] : nullptr, 0, nullptr};
                    pg8::StaticOrder S; S.init(ML, D, G, bid);
                    pg8::gemm_phase<EpiRes, pg8::StaticOrder, true, MK_SP2>(lds, g, S, E);
                }
                if (l < DEPTH - 1) {
                    const int ksl = (Kf == DFF) ? 256 : 128, nks = Kf / ksl;
                    pg8::Gemm g{Ap, Bp, MT, D, ksl, Kf};
                    EpiRes E{modp, (bf16_t*)(ws + WS_XS16), nullptr, 1, (float*)(ws + (k == 7 ? WS_MIX : WS_HB))};
                    pg8::SplitOrder S; S.init(ML / 256, MC / 256, D / 256, nks, G, bid);
                    pg8::gemm_phase<EpiRes, pg8::SplitOrder, true, MK_SP2>(lds, g, S, E);
                }
            }
            else if (k == 6) {
                pg8::Gemm g{(const bf16_t*)(ws + WS_H), (const bf16_t*)(ws + W_FFNIN(l)), MT, NFFN, D, D};
                EpiFFN E{(bf16_t*)(ws + WS_Z)};
                pg8::StaticOrder S; S.init(g.M, g.N, G, bid);
                pg8::gemm_phase<EpiFFN, pg8::StaticOrder, MK_ALIGN, MK_SP2>(lds, g, S, E);
            }
        }
        }
#if PROBE_REP == 5
        GRID_SYNC();
#endif
        if (ph + 1 < a->ph_hi) { if (a->ph_hi > 1000) cg::this_grid().sync(); else GRID_SYNC(); }
    }
}

extern "C" void kernel_launch(void* const* d_in, const int* in_sizes, int n_in, void* d_out, int out_size, void* d_ws, size_t ws_size, hipStream_t stream) {
    static int grid = 0;
    if (grid == 0) {
        if (n_in != N_IN || out_size != ML * D || ws_size < WS_END) { fprintf(stderr, "kernel_launch: unexpected shapes (n_in %d out %d ws %zu)\n", n_in, out_size, ws_size); grid = -1; return; }
        int dev = 0, cus = 0, per_cu = 0;
        if (hipGetDevice(&dev) != hipSuccess || hipDeviceGetAttribute(&cus, hipDeviceAttributeMultiprocessorCount, dev) != hipSuccess) { grid = -1; return; }
        if (hipFuncSetAttribute((const void*)mk_fwd, hipFuncAttributeMaxDynamicSharedMemorySize, LDS_BYTES) != hipSuccess) { fprintf(stderr, "kernel_launch: hipFuncSetAttribute failed\n"); grid = -1; return; }
        if (hipOccupancyMaxActiveBlocksPerMultiprocessor(&per_cu, (const void*)mk_fwd, NTHR, LDS_BYTES) != hipSuccess || per_cu < 1) { fprintf(stderr, "kernel_launch: occupancy query says %d\n", per_cu); per_cu = 1; }
        (void)hipGetLastError();
        grid = cus;
    }
    if (grid < 0) return;
    Args a{};
    for (int i = 0; i < N_IN; ++i) a.in[i] = (const float*)d_in[i];
    a.out = (float*)d_out; a.ws = (unsigned char*)d_ws;
#if MK_MULTI
    for (int ph = 0; ph < 34; ++ph) {
        if (ph >= 1 && ph <= 32) { const int l = (ph - 1) >> 3, k = (ph - 1) & 7; if (k == 3 && !(l & 1)) continue; }
        a.ph_lo = ph; a.ph_hi = ph + 1;
        hipLaunchKernelGGL(mk_fwd, dim3(grid), dim3(NTHR), LDS_BYTES, stream, a);
    }
#else
    a.ph_lo = 0; a.ph_hi = 34;
    if (hipMemsetAsync((char*)d_ws + WS_BAR, 0, 16384, stream) != hipSuccess) { fprintf(stderr, "kernel_launch: memset failed\n"); return; }
    void* args[] = {&a};
    hipError_t e = hipLaunchCooperativeKernel((const void*)mk_fwd, dim3(grid), dim3(NTHR), args, LDS_BYTES, stream);
    if (e != hipSuccess) fprintf(stderr, "cooperative launch failed: %s (grid %d)\n", hipGetErrorString(e), grid);
#endif
}
```

```cpp
#include <hip/hip_runtime.h>
#include <hip/hip_cooperative_groups.h>
#include <cstdio>
#include <cstdint>
namespace cg = cooperative_groups;
#ifndef MK_MULTI
#define MK_MULTI 0
#endif
#ifndef PROBE_REP
#define PROBE_REP 0
#endif
#ifndef USE_XCD_BAR
#define USE_XCD_BAR 1
#endif
#ifndef MK_SP2
#define MK_SP2 true
#endif
#ifndef RG_PREFETCH
#define RG_PREFETCH 1
#endif
#ifndef MK_ALIGN
#define MK_ALIGN true
#endif
__device__ __forceinline__ int mk_opaque_tid() { int t = threadIdx.x; asm volatile("" : "+v"(t)); return t; }
namespace pg8 {
#define PG8_LAS __attribute__((address_space(3)))
typedef unsigned short bf16_t;
typedef short bf16x8 __attribute__((ext_vector_type(8)));
typedef float f32x4 __attribute__((ext_vector_type(4)));
typedef unsigned u32x4 __attribute__((ext_vector_type(4)));
constexpr int BM = 256, BK = 64, HALF = 128, HTB = HALF * BK * 2  , STAGE_BYTES = 8 * HTB, NXCD = 8, WGM = 8;

__host__ __device__ __forceinline__ int lds_byte(int r, int c) { const int st = (r >> 4) * 2 + (c >> 5), rr = r & 15, cc = c & 31, ob = rr * 64 + cc * 2; return st * 1024 + (ob ^ (((ob >> 9) & 1) << 5)); }
__host__ __device__ __forceinline__ void stage_rc(int b, int& R, int& C) { const int st = b / 1024, sb = b % 1024, swz = sb ^ (((sb >> 9) & 1) << 5); R = (st >> 1) * 16 + swz / 64; C = (st & 1) * 32 + (swz % 64) / 2; }
__host__ __device__ __forceinline__ int perm32(int rho) { const int n = rho >> 4, i = rho & 15; return 8 * (i >> 2) + 4 * n + (i & 3); }

struct Unit { int pm, pn, ks, sw; };
struct Gemm { const bf16_t* A; const bf16_t* Bt; int M, N, K, ld; };

struct StaticOrder {
    int nM, nN, nwg, G, c;
    __host__ __device__ void init(int M, int N, int G_, int c_) { nM = M / BM; nN = N / BM; nwg = nM * nN; G = G_; c = c_; }
    __host__ __device__ bool next(int i, Unit& u) const {
        const long L = (long)i * G + c; if (L >= nwg) return false;
        int wgid = (int)L; { const int q = nwg / NXCD, r = nwg % NXCD, xcd = wgid % NXCD, off = wgid / NXCD; wgid = (xcd < r ? xcd * (q + 1) : r * (q + 1) + (xcd - r) * q) + off; }
        const int nig = WGM * nN, gid = wgid / nig, fm = gid * WGM, gsz = (nM - fm) < WGM ? (nM - fm) : WGM;
        u.pm = fm + ((wgid % nig) % gsz); u.pn = (wgid % nig) / gsz; u.ks = 0; u.sw = 0; return true;
    }
    __device__ __forceinline__ void a_ready(const Unit&) const {}
    __device__ __forceinline__ void done(const Unit&) const {}
};
struct SplitOrder {
    int pm0, nN, nks, total, G, c;
    __host__ __device__ void init(int pm0_, int nM_, int nN_, int nks_, int G_, int c_) { pm0 = pm0_; nN = nN_; nks = nks_; total = nM_ * nN_ * nks_; G = G_; c = c_; }
    __host__ __device__ bool next(int i, Unit& u) const { const long L = (long)i * G + c; if (L >= total) return false; const int l = (int)L; u.ks = l % nks; u.sw = 0; const int t = l / nks; u.pm = pm0 + t / nN; u.pn = t % nN; return true; }
    __device__ __forceinline__ void a_ready(const Unit&) const {}
    __device__ __forceinline__ void done(const Unit&) const {}
};
struct MergedOrder {
    int G, c;
    __host__ __device__ void init(int G_, int c_) { G = G_; c = c_; }
    __host__ __device__ bool next(int i, Unit& u) const { const long L = (long)i * G + c; if (L >= 680) return false; const int l = (int)L, w = (l % 8) * 85 + l / 8;
        u.ks = 0; if (w < 408) { u.sw = 1; u.pm = w % 6; u.pn = w / 6; } else { const int t = w - 408; u.sw = 0; u.pm = t / 4; u.pn = 6 + t % 4; } return true; }
    __device__ __forceinline__ void a_ready(const Unit&) const {}
    __device__ __forceinline__ void done(const Unit&) const {}
};
__device__ __forceinline__ unsigned cvt_pk_bf16(float lo, float hi) { unsigned r; asm volatile("v_cvt_pk_bf16_f32 %0, %1, %2" : "=v"(r) : "v"(lo), "v"(hi)); return r; }
template <class Epi, class Sched, bool ALIGN_EPI = false, bool SP2 = false>
__device__ __forceinline__ void gemm_phase(PG8_LAS unsigned char* lds, const Gemm g, const Sched& S, const Epi& E) {
    const int tid = mk_opaque_tid(), wid = __builtin_amdgcn_readfirstlane(tid >> 6), lane = tid & 63, wr = wid >> 2, wc = wid & 3, fr = lane & 15, fq = lane >> 4;
    const int K = g.K, nt = K / BK;
    unsigned voffA[2], voffB[2];
#pragma unroll
    for (int i = 0; i < 2; ++i) { int R, C; stage_rc(tid * 16 + i * 8192, R, C); const int Rb = Epi::PERM ? ((R & ~31) + perm32(R & 31)) : R;
        voffA[i] = (unsigned)(R * g.ld + C) * 2u; voffB[i] = (unsigned)(Rb * g.ld + C) * 2u; }
    const size_t kstep = (size_t)(BK * 2);
    const size_t hstep = (size_t)HALF * g.ld * 2;
    const size_t tstep = 2 * hstep;
    const unsigned ldsw = (unsigned)wid * 1024u;
    const int aoff = lds_byte(wr * 64 + fr, fq * 8), boff = lds_byte(wc * 32 + fr, fq * 8);
#define PG8_SA(b, h) (((b) * 2 + (h)) * HTB)
#define PG8_SB(b, h) ((4 + (b) * 2 + (h)) * HTB)
#define PG8_STAGE(bufoff, gbase, voff) do { _Pragma("unroll") for (int _i = 0; _i < 2; ++_i) \
        __builtin_amdgcn_global_load_lds((const unsigned*)((const char*)(gbase) + (voff)[_i]), (PG8_LAS unsigned*)(lds + (bufoff) + ldsw + _i * 8192), 16, 0, 0); } while (0)
#define PG8_LDA(dst, b, h) do { _Pragma("unroll") for (int m = 0; m < 4; ++m) _Pragma("unroll") for (int k = 0; k < 2; ++k) dst[m][k] = *(const PG8_LAS bf16x8*)(lds + PG8_SA(b, h) + aoff + m * 2048 + k * 1024); } while (0)
#define PG8_LDB(dst, b, h) do { _Pragma("unroll") for (int n = 0; n < 2; ++n) _Pragma("unroll") for (int k = 0; k < 2; ++k) dst[n][k] = *(const PG8_LAS bf16x8*)(lds + PG8_SB(b, h) + boff + n * 2048 + k * 1024); } while (0)
#define PG8_MMA(ai, bj, At, Bt) do { __builtin_amdgcn_s_setprio(1); _Pragma("unroll") for (int m = 0; m < 4; ++m) _Pragma("unroll") for (int n = 0; n < 2; ++n) _Pragma("unroll") for (int k = 0; k < 2; ++k) \
        acc[ai][bj][m][n] = __builtin_amdgcn_mfma_f32_16x16x32_bf16(Bt[n][k], At[m][k], acc[ai][bj][m][n], 0, 0, 0); __builtin_amdgcn_s_setprio(0); } while (0)
#define PG8_WAIT_V(n) asm volatile("s_waitcnt vmcnt(" #n ")" ::: "memory")
#define PG8_WAIT_L(n) asm volatile("s_waitcnt lgkmcnt(" #n ")" ::: "memory")
#define PG8_BAR __builtin_amdgcn_s_barrier()
#define PG8_SCHED __builtin_amdgcn_sched_barrier(0)
    Unit cur, nxt; int ui = 0;
    if (!S.next(0, cur)) return;
    f32x4 acc[2][2][4][2];
#pragma unroll
    for (int a = 0; a < 2; ++a)
#pragma unroll
        for (int b = 0; b < 2; ++b)
#pragma unroll
            for (int m = 0; m < 4; ++m)
#pragma unroll
                for (int n = 0; n < 2; ++n) acc[a][b][m][n] = (f32x4){0.f, 0.f, 0.f, 0.f};
    bf16x8 At[4][2], B0[2][2], B1[2][2];
    const size_t sstep = (size_t)K * 2;
    const char* cA = (const char*)(cur.sw ? g.Bt : g.A) + (size_t)cur.pm * tstep + (size_t)cur.ks * sstep; const char* cB = (const char*)(cur.sw ? g.A : g.Bt) + (size_t)cur.pn * tstep + (size_t)cur.ks * sstep;
    S.a_ready(cur);
    if constexpr (SP2) {
        PG8_STAGE(PG8_SB(0, 0), cB, voffB); PG8_STAGE(PG8_SB(0, 1), cB + hstep, voffB); PG8_STAGE(PG8_SA(0, 0), cA, voffA); PG8_STAGE(PG8_SA(0, 1), cA + hstep, voffA);
        if (wr == 1) PG8_BAR;
        PG8_WAIT_V(2); PG8_BAR;
        PG8_STAGE(PG8_SB(1, 0), cB + kstep, voffB); PG8_STAGE(PG8_SA(1, 0), cA + kstep, voffA); PG8_STAGE(PG8_SB(1, 1), cB + hstep + kstep, voffB);
        PG8_WAIT_V(6); PG8_BAR;
    } else {
        PG8_STAGE(PG8_SB(0, 0), cB, voffB); PG8_STAGE(PG8_SA(0, 0), cA, voffA); PG8_STAGE(PG8_SB(0, 1), cB + hstep, voffB); PG8_STAGE(PG8_SA(0, 1), cA + hstep, voffA);
        if (wr == 1) PG8_BAR;
        PG8_WAIT_V(4); PG8_BAR;
        PG8_STAGE(PG8_SB(1, 0), cB + kstep, voffB); PG8_STAGE(PG8_SA(1, 0), cA + kstep, voffA); PG8_STAGE(PG8_SB(1, 1), cB + hstep + kstep, voffB);
        PG8_WAIT_V(6); PG8_BAR;
    }
    for (;;) {
        const bool has_next = S.next(ui + 1, nxt);
        const char* nA = has_next ? (const char*)(nxt.sw ? g.Bt : g.A) + (size_t)nxt.pm * tstep + (size_t)nxt.ks * sstep : cA; const char* nB = has_next ? (const char*)(nxt.sw ? g.A : g.Bt) + (size_t)nxt.pn * tstep + (size_t)nxt.ks * sstep : cB;
        for (int t = 0; t < nt; t += 2) {
            const bool last = (t == nt - 2);
            const char* a1 = cA + (size_t)(t + 1) * kstep;
            const char* a2 = last ? nA : cA + (size_t)(t + 2) * kstep; const char* b2 = last ? nB : cB + (size_t)(t + 2) * kstep;
            const char* a3 = a2 + kstep; const char* b3 = b2 + kstep;
            if (last && has_next) S.a_ready(nxt);
            if constexpr (SP2) {
            PG8_LDB(B0, 0, 0); PG8_LDB(B1, 0, 1); PG8_SCHED; PG8_LDA(At, 0, 0); PG8_STAGE(PG8_SA(1, 1), a1 + hstep, voffA);
            PG8_WAIT_V(8); PG8_WAIT_L(0); PG8_BAR; PG8_MMA(0, 0, At, B0); PG8_MMA(0, 1, At, B1); PG8_BAR; PG8_SCHED;
            PG8_LDA(At, 0, 1); PG8_STAGE(PG8_SB(0, 0), b2, voffB); PG8_STAGE(PG8_SB(0, 1), b2 + hstep, voffB); PG8_STAGE(PG8_SA(0, 0), a2, voffA);
            PG8_WAIT_V(8); PG8_WAIT_L(0); PG8_BAR; PG8_MMA(1, 0, At, B0); PG8_MMA(1, 1, At, B1); PG8_BAR; PG8_SCHED;
            PG8_LDB(B0, 1, 0); PG8_LDB(B1, 1, 1); PG8_SCHED; PG8_LDA(At, 1, 0); PG8_STAGE(PG8_SA(0, 1), a2 + hstep, voffA);
            PG8_WAIT_V(8); PG8_WAIT_L(0); PG8_BAR; PG8_MMA(0, 0, At, B0); PG8_MMA(0, 1, At, B1); PG8_BAR; PG8_SCHED;
            PG8_LDA(At, 1, 1); PG8_STAGE(PG8_SB(1, 0), b3, voffB); PG8_STAGE(PG8_SB(1, 1), b3 + hstep, voffB); PG8_STAGE(PG8_SA(1, 0), a3, voffA);
            PG8_WAIT_V(8); PG8_WAIT_L(0); PG8_BAR; PG8_MMA(1, 0, At, B0); PG8_MMA(1, 1, At, B1); PG8_BAR; PG8_SCHED;
            } else {
            PG8_LDB(B0, 0, 0); PG8_SCHED; PG8_LDA(At, 0, 0); PG8_STAGE(PG8_SA(1, 1), a1 + hstep, voffA);
            PG8_WAIT_L(8); PG8_BAR; PG8_WAIT_L(0); PG8_MMA(0, 0, At, B0); PG8_BAR; PG8_SCHED;
            PG8_LDB(B1, 0, 1); PG8_STAGE(PG8_SB(0, 0), b2, voffB);
            PG8_BAR; PG8_WAIT_L(0); PG8_MMA(0, 1, At, B1); PG8_BAR;
            PG8_LDA(At, 0, 1); PG8_STAGE(PG8_SA(0, 0), a2, voffA);
            PG8_BAR; PG8_WAIT_L(0); PG8_MMA(1, 0, At, B0); PG8_BAR; PG8_SCHED;
            PG8_STAGE(PG8_SB(0, 1), b2 + hstep, voffB);
            PG8_WAIT_V(6); PG8_BAR; PG8_MMA(1, 1, At, B1); PG8_BAR;
            PG8_LDB(B0, 1, 0); PG8_SCHED; PG8_LDA(At, 1, 0); PG8_STAGE(PG8_SA(0, 1), a2 + hstep, voffA);
            PG8_WAIT_L(8); PG8_BAR; PG8_WAIT_L(0); PG8_MMA(0, 0, At, B0); PG8_BAR; PG8_SCHED;
            PG8_LDB(B1, 1, 1); PG8_STAGE(PG8_SB(1, 0), b3, voffB);
            PG8_BAR; PG8_WAIT_L(0); PG8_MMA(0, 1, At, B1); PG8_BAR;
            PG8_LDA(At, 1, 1); PG8_STAGE(PG8_SA(1, 0), a3, voffA);
            PG8_BAR; PG8_WAIT_L(0); PG8_MMA(1, 0, At, B0); PG8_BAR; PG8_SCHED;
            PG8_STAGE(PG8_SB(1, 1), b3 + hstep, voffB);
            PG8_WAIT_V(6); PG8_BAR; PG8_MMA(1, 1, At, B1); PG8_BAR;
            }
        }
        if constexpr (ALIGN_EPI) { if (wr == 0) PG8_BAR; }
        if constexpr (!Epi::AFTER_DRAIN) { E(acc, cur, wr, wc, fr, fq); S.done(cur); }
        if (!has_next) break;
#pragma unroll
        for (int a = 0; a < 2; ++a)
#pragma unroll
            for (int b = 0; b < 2; ++b)
#pragma unroll
                for (int m = 0; m < 4; ++m)
#pragma unroll
                    for (int n = 0; n < 2; ++n) acc[a][b][m][n] = (f32x4){0.f, 0.f, 0.f, 0.f};
        cur = nxt; cA = nA; cB = nB; ++ui;
        if constexpr (ALIGN_EPI) { if (wr == 1) PG8_BAR; }
    }
    PG8_WAIT_V(0);
    if constexpr (!ALIGN_EPI) { if (wr == 0) PG8_BAR; }
    PG8_BAR;
    if constexpr (Epi::AFTER_DRAIN) { E.fused(acc, cur, wr, wc, fr, fq, lds, wid, lane); S.done(cur); }
#undef PG8_SA
#undef PG8_SB
#undef PG8_STAGE
#undef PG8_LDA
#undef PG8_LDB
#undef PG8_MMA
#undef PG8_WAIT_V
#undef PG8_WAIT_L
#undef PG8_BAR
#undef PG8_SCHED
}
}

#define LAS __attribute__((address_space(3)))
typedef unsigned short bf16_t;
typedef float f32x4 __attribute__((ext_vector_type(4)));
typedef float f32x2 __attribute__((ext_vector_type(2)));
typedef unsigned u32x4 __attribute__((ext_vector_type(4)));
typedef unsigned u32x2 __attribute__((ext_vector_type(2)));
typedef short bf16x8 __attribute__((ext_vector_type(8)));

constexpr int D = 1024, NB = 4, SEQ = 4096, CTXL = 256, DEPTH = 4;
constexpr int ML = NB * SEQ, MC = NB * CTXL, MT = ML + MC;
constexpr int NEIN = 2560, DRNN = 1408, NOIN = 2816, DFF = 2816, NFFN = 5632, NMOD = 6144;
constexpr int NT_ALL = SEQ + CTXL;
constexpr float EPS = 1e-6f;
constexpr int NTHR = 512, NWAVES = 8;
constexpr int LDS_BYTES = 147456;

constexpr size_t MiB = 1u << 20;
constexpr size_t WS_MOD = 0;
constexpr size_t WS_BAR = 512 * 1024;
constexpr size_t WS_HDN = 1 * MiB;
constexpr size_t WS_RGW = 4 * MiB;
constexpr size_t WS_XSC = 8 * MiB;
constexpr size_t WS_W   = 12 * MiB;
constexpr size_t WS_H   = 109 * MiB;
constexpr size_t WS_Z   = 143 * MiB;
constexpr size_t WS_MIX = 237 * MiB;
constexpr size_t WS_HB  = 284 * MiB;
constexpr size_t WS_XS16 = 331 * MiB;
constexpr size_t WS_END = 365 * MiB;
__host__ __device__ constexpr size_t W_FFNIN(int l)  { return WS_W + (size_t)l * (33 * MiB / 2); }
__host__ __device__ constexpr size_t W_FFNOUT(int l) { return W_FFNIN(l) + 11 * MiB; }
__host__ __device__ constexpr size_t W_EIN(int i)    { return WS_W + 66 * MiB + (size_t)i * 7 * MiB; }
__host__ __device__ constexpr size_t W_EOUT(int i)   { return W_EIN(i) + 5 * MiB; }
__host__ __device__ constexpr size_t W_OIN(int i)    { return WS_W + 80 * MiB + (size_t)i * (33 * MiB / 4); }
__host__ __device__ constexpr size_t W_OOUT(int i)   { return W_OIN(i) + 11 * MiB / 2; }

enum { I_X = 0, I_C, I_CTX, I_CCTX, I_WADA, I_BADA, I_GMIX, I_GFFN, I_WINE, I_WOUTE, I_HCW, I_HCB, I_F1W, I_F1B, I_F2W, I_F2B, I_F3W, I_F3B, I_SINF, I_SKIP,
       I_LNG, I_SGUW, I_SGUB, I_WINO, I_RCW, I_RCB, I_RWA, I_RBA, I_RWX, I_RBX, I_LAM, I_WOUTO, I_WFIN, I_WFOUT, I_FING, N_IN };
struct Args { const float* in[N_IN]; float* out; unsigned char* ws; int ph_lo, ph_hi; };
typedef const __attribute__((address_space(4))) Args* KA;

__device__ __forceinline__ unsigned f2bf(float f) { unsigned u = __builtin_bit_cast(unsigned, f); return (u + 0x7fffu + ((u >> 16) & 1u)) >> 16; }
__device__ __forceinline__ unsigned pk2(float lo, float hi) { return pg8::cvt_pk_bf16(lo, hi); }
__device__ __forceinline__ float bf2f(unsigned h) { return __builtin_bit_cast(float, h << 16); }
__device__ __forceinline__ float bflo(unsigned w) { return __builtin_bit_cast(float, w << 16); }
__device__ __forceinline__ float bfhi(unsigned w) { return __builtin_bit_cast(float, w & 0xffff0000u); }
__device__ __forceinline__ float wave_sum(float v) {
#pragma unroll
    for (int o = 1; o < 64; o <<= 1) v += __shfl_xor(v, o);
    return v;
}
__device__ __forceinline__ float sigmoidf_(float x) { return __builtin_amdgcn_rcpf(1.0f + __builtin_amdgcn_exp2f(-1.4426950408889634f * x)); }
__device__ __forceinline__ float silu_(float x) { return x * sigmoidf_(x); }
__device__ __forceinline__ float gelu_tanh(float x) {
    const float q = __builtin_fmaf(x * x, -0.10294324f, -2.3022082f); return x * __builtin_amdgcn_rcpf(1.0f + __builtin_amdgcn_exp2f(x * q)); }
__device__ __forceinline__ float* xs_row(KA a, int row) { return row < ML ? a->out + (size_t)row * D : (float*)(a->ws + WS_XSC) + (size_t)(row - ML) * D; }

#define XB_TMO      128
#define XB_XCNT(j)  (256  + 64 * (j))
#define XB_XSUB(j)  (1280 + 64 * (j))
#define XB_XGEN(j)  (2304 + 64 * (j))
#define XB_TOP      3328
#define XB_TOPGEN   3392
#define XCD_BAR_WORDS 3456
#define XB_SPIN_CAP (1u << 18)

__device__ __forceinline__ unsigned xb_ld(unsigned* p)              { return __hip_atomic_load(p, __ATOMIC_RELAXED, __HIP_MEMORY_SCOPE_AGENT); }
__device__ __forceinline__ unsigned xb_add(unsigned* p, unsigned v) { return __hip_atomic_fetch_add(p, v, __ATOMIC_RELAXED, __HIP_MEMORY_SCOPE_AGENT); }
__device__ __forceinline__ unsigned xb_xcc_id() { return (unsigned)__builtin_amdgcn_s_getreg((3 << 11) | 20) & 0xFu; }
#define XB_SPIN(cond, bar) do { unsigned _sp = 0; while (cond) { __builtin_amdgcn_s_sleep(1); \
    if ((++_sp & 255u) == 0u) { if (xb_ld(&(bar)[XB_TMO])) break; if (_sp > XB_SPIN_CAP) { atomicAdd(&(bar)[XB_TMO], 1u); break; } } } } while (0)

struct XcdBarrier {
    unsigned* bar; unsigned x;
    volatile LAS unsigned* st;
};

__device__ __forceinline__ XcdBarrier xcd_barrier_post(unsigned* bar, volatile LAS unsigned* st) {
    XcdBarrier b; b.bar = bar; b.x = xb_xcc_id(); b.st = st;
    if (threadIdx.x == 0) (void)xb_add(&bar[XB_XCNT(b.x)], 1u);
    return b;
}
__device__ __forceinline__ void xcd_barrier_complete(unsigned* bar, unsigned x, unsigned& nloc, unsigned& nx) {
    const unsigned G = gridDim.x * gridDim.y * gridDim.z;
    unsigned sum, cnt, mine, sp = 0u;
    for (;;) {
        sum = 0u; cnt = 0u; mine = 0u;
#pragma unroll
        for (unsigned j = 0; j < 16; ++j) { const unsigned c = xb_ld(&bar[XB_XCNT(j)]); sum += c; cnt += (c > 0u) ? 1u : 0u; mine = (j == x) ? c : mine; }
        if (sum == G) break;
        __builtin_amdgcn_s_sleep(1);
        if ((++sp & 255u) == 0u) { if (xb_ld(&bar[XB_TMO])) break; if (sp > XB_SPIN_CAP) { atomicAdd(&bar[XB_TMO], 1u); break; } }
    }
    nloc = mine > 0u ? mine : 1u; nx = cnt > 0u ? cnt : 1u;
}

__device__ __forceinline__ void xcd_barrier(const XcdBarrier& b) {
    asm volatile("s_waitcnt vmcnt(0)" ::: "memory");
    __syncthreads();
    if (threadIdx.x == 0) {
        unsigned* bar = b.bar;
        __builtin_amdgcn_s_waitcnt(0);
        unsigned nloc = b.st[0], nx = b.st[1];
        if (nloc == 0u) { xcd_barrier_complete(bar, b.x, nloc, nx); b.st[0] = nloc; b.st[1] = nx; }
        const unsigned old = xb_add(&bar[XB_XSUB(b.x)], 1u);
        const unsigned gen = old / nloc;
        if (old + 1u == (gen + 1u) * nloc) {
            __builtin_amdgcn_fence(__ATOMIC_RELEASE, "agent");
            asm volatile("s_waitcnt vmcnt(0)" ::: "memory");
            const unsigned og = xb_add(&bar[XB_TOP], 1u);
            const unsigned tg = og / nx;
            if (og + 1u == (tg + 1u) * nx) xb_add(&bar[XB_TOPGEN], 1u);
            else XB_SPIN(xb_ld(&bar[XB_TOPGEN]) == tg, bar);
            __builtin_amdgcn_fence(__ATOMIC_ACQUIRE, "agent");
            xb_add(&bar[XB_XGEN(b.x)], 1u);
            asm volatile("s_waitcnt vmcnt(0)" ::: "memory");
        } else {
            XB_SPIN(xb_ld(&bar[XB_XGEN(b.x)]) == gen, bar);
            __builtin_amdgcn_fence(__ATOMIC_ACQUIRE, "agent");
            asm volatile("s_waitcnt vmcnt(0)" ::: "memory");
        }
    }
    __syncthreads();
}

struct EpiStore {
    static constexpr bool PERM = true, AFTER_DRAIN = false;
    bf16_t* O_; int ldc_; int gelu_blocks_;  bf16_t* O2; int ldc2;
    __device__ __forceinline__ void operator()(const f32x4 (&acc)[2][2][4][2], const pg8::Unit& u, int wr, int wc, int fr, int fq) const {
        bf16_t* O = u.sw ? O2 : O_; const int ldc = u.sw ? ldc2 : ldc_, gelu_blocks = u.sw ? 0 : gelu_blocks_;
        const int row0 = u.pm * 256 + wr * 64 + fr, col0 = u.pn * 256 + wc * 32 + 8 * fq;
#pragma unroll
        for (int ai = 0; ai < 2; ++ai)
#pragma unroll
            for (int m = 0; m < 4; ++m) { bf16_t* rowp = O + (size_t)(row0 + ai * 128 + m * 16) * ldc + col0;
#pragma unroll
                for (int bj = 0; bj < 2; ++bj) { f32x4 v0 = acc[ai][bj][m][0], v1 = acc[ai][bj][m][1];
                    if (2 * u.pn + bj < gelu_blocks) {
#pragma unroll
                        for (int j = 0; j < 4; ++j) { v0[j] = gelu_tanh(v0[j]); v1[j] = gelu_tanh(v1[j]); } }
                    u32x4 w; w.x = pk2(v0[0], v0[1]); w.y = pk2(v0[2], v0[3]); w.z = pk2(v1[0], v1[1]); w.w = pk2(v1[2], v1[3]);
                    *(u32x4*)(rowp + bj * 128) = w; } }
    }
};
struct EpiFFN {
    static constexpr bool PERM = true, AFTER_DRAIN = false;
    bf16_t* O;
    __device__ __forceinline__ void operator()(const f32x4 (&acc)[2][2][4][2], const pg8::Unit& u, int wr, int wc, int fr, int fq) const {
        const int row0 = u.pm * 256 + wr * 64 + fr, col0 = u.pn * 128 + wc * 32 + 8 * fq;
#pragma unroll
        for (int ai = 0; ai < 2; ++ai)
#pragma unroll
            for (int m = 0; m < 4; ++m) { bf16_t* rowp = O + (size_t)(row0 + ai * 128 + m * 16) * DFF + col0;
                f32x4 v0, v1;
#pragma unroll
                for (int j = 0; j < 4; ++j) { v0[j] = silu_(acc[ai][0][m][0][j]) * acc[ai][1][m][0][j]; v1[j] = silu_(acc[ai][0][m][1][j]) * acc[ai][1][m][1][j]; }
                u32x4 w; w.x = pk2(v0[0], v0[1]); w.y = pk2(v0[2], v0[3]); w.z = pk2(v1[0], v1[1]); w.w = pk2(v1[2], v1[3]);
                *(u32x4*)rowp = w; }
    }
};
struct EpiRes {
    static constexpr bool PERM = true, AFTER_DRAIN = false;
    const float* mod;    bf16_t* xs;
    const float* xsrc;
    int split;
    float* part;
    __device__ __forceinline__ void operator()(const f32x4 (&acc)[2][2][4][2], const pg8::Unit& u, int wr, int wc, int fr, int fq) const {
        const int row0 = u.pm * 256 + wr * 64 + fr, col0 = u.pn * 256 + wc * 32 + 8 * fq;
        const int mrow = u.pm < 64 ? (u.pm >> 4) : 4;
        const float* mp = mod + mrow * NMOD + col0;
        f32x4 mv[2][2];
#pragma unroll
        for (int bj = 0; bj < 2; ++bj)
#pragma unroll
            for (int n = 0; n < 2; ++n) mv[bj][n] = *(const f32x4*)(mp + bj * 128 + n * 4);
        if (split) {
#pragma unroll
            for (int ai = 0; ai < 2; ++ai)
#pragma unroll
                for (int m = 0; m < 4; ++m) { const int r = row0 + ai * 128 + m * 16;
                    float* pp = part + ((size_t)u.ks * MC + (size_t)(r - ML)) * D + col0;
#pragma unroll
                    for (int bj = 0; bj < 2; ++bj) { *(f32x4*)(pp + bj * 128) = acc[ai][bj][m][0]; *(f32x4*)(pp + bj * 128 + 4) = acc[ai][bj][m][1]; } }
        } else if (xsrc) {
#pragma unroll
            for (int ai = 0; ai < 2; ++ai)
#pragma unroll
                for (int m = 0; m < 4; ++m) { const int r = row0 + ai * 128 + m * 16; bf16_t* xp = xs + (size_t)r * D + col0;
#pragma unroll
                    for (int bj = 0; bj < 2; ++bj) { const float* sp = xsrc + (size_t)r * D + col0 + bj * 128; f32x4 o0 = *(const f32x4*)sp, o1 = *(const f32x4*)(sp + 4);
                        o0 += mv[bj][0] * acc[ai][bj][m][0]; o1 += mv[bj][1] * acc[ai][bj][m][1];
                        u32x4 w2; w2.x = pk2(o0.x, o0.y); w2.y = pk2(o0.z, o0.w); w2.z = pk2(o1.x, o1.y); w2.w = pk2(o1.z, o1.w);
                        *(u32x4*)(xp + bj * 128) = w2; }
                    asm volatile("" ::: "memory"); }
        } else {
#pragma unroll
            for (int ai = 0; ai < 2; ++ai) {
                u32x4 oldw[4][2];
#pragma unroll
                for (int m = 0; m < 4; ++m)
#pragma unroll
                    for (int bj = 0; bj < 2; ++bj) oldw[m][bj] = *(const u32x4*)(xs + (size_t)(row0 + ai * 128 + m * 16) * D + col0 + bj * 128);
#pragma unroll
                for (int m = 0; m < 4; ++m) { bf16_t* xp = xs + (size_t)(row0 + ai * 128 + m * 16) * D + col0;
#pragma unroll
                    for (int bj = 0; bj < 2; ++bj) { const u32x4 w = oldw[m][bj];
                        f32x4 o0 = (f32x4){bflo(w.x), bfhi(w.x), bflo(w.y), bfhi(w.y)}, o1 = (f32x4){bflo(w.z), bfhi(w.z), bflo(w.w), bfhi(w.w)};
                        o0 += mv[bj][0] * acc[ai][bj][m][0]; o1 += mv[bj][1] * acc[ai][bj][m][1];
                        u32x4 w2; w2.x = pk2(o0.x, o0.y); w2.y = pk2(o0.z, o0.w); w2.z = pk2(o1.x, o1.y); w2.w = pk2(o1.z, o1.w);
                        *(u32x4*)(xp + bj * 128) = w2; } }
                asm volatile("" ::: "memory");
            }
        }
    }
};

__device__ __forceinline__ void p0_transpose_item(const float* W, int K, int N, bf16_t* WT, int mode, LAS float* scr, int item, int lane) {
    const int nblk = N / 32, kb = item / nblk, nb = item % nblk, k0 = 64 * kb, n0 = 32 * nb;
    int rowbase = n0;
    if (mode == 1) { const int half = n0 >= DFF ? 1 : 0, nn = n0 - half * DFF; rowbase = 256 * (nn >> 7) + 128 * half + (nn & 127); }
#pragma unroll 8
    for (int i = 0; i < 32; ++i) { const int kk = 2 * i + (lane >> 5); scr[kk * 33 + (lane & 31)] = W[(size_t)(k0 + kk) * N + n0 + (lane & 31)]; }
    asm volatile("s_waitcnt lgkmcnt(0)" ::: "memory");
    const int c = lane & 7;
#pragma unroll
    for (int j = 0; j < 4; ++j) { const int n = (lane >> 3) + 8 * j; const LAS float* s = scr + (8 * c) * 33 + n;
        u32x4 o; o.x = pk2(s[0 * 33], s[1 * 33]); o.y = pk2(s[2 * 33], s[3 * 33]); o.z = pk2(s[4 * 33], s[5 * 33]); o.w = pk2(s[6 * 33], s[7 * 33]);
        *(u32x4*)(WT + (size_t)(rowbase + n) * K + k0 + 8 * c) = o; }
    asm volatile("s_waitcnt lgkmcnt(0)" ::: "memory");
}

struct P0Item { const float* W; bf16_t* WT; int K, N, k0, n0, rowbase; };
__device__ __forceinline__ P0Item p0_make(const float* W, int K, int N, bf16_t* WT, int mode, int item) {
    P0Item q; q.W = W; q.WT = WT; q.K = K; q.N = N; const int nblk = N / 32, kb = item / nblk, nb = item % nblk; q.k0 = 64 * kb; q.n0 = 32 * nb; q.rowbase = q.n0;
    if (mode == 1) { const int half = q.n0 >= DFF ? 1 : 0, nn = q.n0 - half * DFF; q.rowbase = 256 * (nn >> 7) + 128 * half + (nn & 127); }
    return q;
}
__device__ __forceinline__ P0Item p0_decode(KA a, int it) {
    unsigned char* ws = a->ws;
    if (it < 16896) { const int l = it / 4224, r = it % 4224;
        if (r < 2816) return p0_make(a->in[I_WFIN] + (size_t)l * D * NFFN, D, NFFN, (bf16_t*)(ws + W_FFNIN(l)), 1, r);
        return p0_make(a->in[I_WFOUT] + (size_t)l * DFF * D, DFF, D, (bf16_t*)(ws + W_FFNOUT(l)), 0, r - 2816); }
    it -= 16896;
    if (it < 3584) { const int i = it / 1792, r = it % 1792;
        if (r < 1280) return p0_make(a->in[I_WINE] + (size_t)i * D * NEIN, D, NEIN, (bf16_t*)(ws + W_EIN(i)), 0, r);
        return p0_make(a->in[I_WOUTE] + (size_t)i * D * D, D, D, (bf16_t*)(ws + W_EOUT(i)), 0, r - 1280); }
    it -= 3584;
    { const int i = it / 2112, r = it % 2112;
        if (r < 1408) return p0_make(a->in[I_WINO] + (size_t)i * D * NOIN, D, NOIN, (bf16_t*)(ws + W_OIN(i)), 0, r);
        return p0_make(a->in[I_WOUTO] + (size_t)i * DRNN * D, DRNN, D, (bf16_t*)(ws + W_OOUT(i)), 0, r - 1408); }
}
__device__ __forceinline__ void p0_store_item(const P0Item& q, const float (&r)[32], LAS float* scr, int lane) {
#pragma unroll
    for (int i = 0; i < 32; ++i) scr[(2 * i + (lane >> 5)) * 33 + (lane & 31)] = r[i];
    asm volatile("s_waitcnt lgkmcnt(0)" ::: "memory");
    const int c = lane & 7;
#pragma unroll
    for (int j = 0; j < 4; ++j) { const int n = (lane >> 3) + 8 * j; const LAS float* s = scr + (8 * c) * 33 + n;
        u32x4 o; o.x = pk2(s[0 * 33], s[1 * 33]); o.y = pk2(s[2 * 33], s[3 * 33]); o.z = pk2(s[4 * 33], s[5 * 33]); o.w = pk2(s[6 * 33], s[7 * 33]);
        *(u32x4*)(q.WT + (size_t)(q.rowbase + n) * q.K + q.k0 + 8 * c) = o; }
    asm volatile("s_waitcnt lgkmcnt(0)" ::: "memory");
}
__device__ __forceinline__ void phase0(KA a, LAS unsigned char* lds, int tid, int lane, int wave, int bid, int G) {
    unsigned char* ws = a->ws;
    {
        LAS float* sv = (LAS float*)lds;
        LAS float* part = (LAS float*)(lds + 32768);
        for (int i = tid; i < 5 * 1024; i += NTHR) { const int r = i >> 10, k = i & 1023; const float v = (r < 4) ? a->in[I_C][r * 1024 + k] : a->in[I_CCTX][k]; sv[i] = silu_(v); }
        __syncthreads();
        float* mod = (float*)(ws + WS_MOD);
        for (int it = bid; it < 192; it += G) {
            const int l = it / 48, n0 = (it % 48) * 128;
            const float* W = a->in[I_WADA] + (size_t)l * 1024 * NMOD;
            const int cgp = lane & 31, kp = lane >> 5;
            f32x4 acc[5];
#pragma unroll
            for (int r = 0; r < 5; ++r) acc[r] = (f32x4){0.f, 0.f, 0.f, 0.f};
#pragma unroll 16
            for (int i = 0; i < 64; ++i) { const int k = wave * 128 + 2 * i + kp; const f32x4 w = __builtin_nontemporal_load((const f32x4*)(W + (size_t)k * NMOD + n0 + 4 * cgp));
#pragma unroll
                for (int r = 0; r < 5; ++r) acc[r] += sv[r * 1024 + k] * w; }
            const int slot = wave * 2 + kp;
#pragma unroll
            for (int r = 0; r < 5; ++r) *(LAS f32x4*)(part + (slot * 5 + r) * 128 + 4 * cgp) = acc[r];
            __syncthreads();
            for (int o = tid; o < 640; o += NTHR) { const int r = o >> 7, n = o & 127; float s = a->in[I_BADA][l * NMOD + n0 + n];
#pragma unroll
                for (int sl = 0; sl < 16; ++sl) s += part[(sl * 5 + r) * 128 + n];
                mod[(size_t)(l * 5 + r) * NMOD + n0 + n] = s; }
            __syncthreads();
        }
    }
    {
        LAS float* scr0 = (LAS float*)(lds + wave * 17408); LAS float* scr1 = scr0 + 2176;
        const int gw = bid * NWAVES + wave, NGW = G * NWAVES;
        const bool reb = (G == 256);
        const int lim1 = reb ? 22528 : 24704;
        for (int it0 = gw; it0 < lim1; it0 += 2 * NGW) {
            float ra[32], rb[32]; const bool two = it0 + NGW < lim1; P0Item A = p0_decode(a, it0), B = p0_decode(a, two ? it0 + NGW : it0);
#pragma unroll
            for (int i = 0; i < 32; ++i) ra[i] = __builtin_nontemporal_load(&A.W[(size_t)(A.k0 + 2 * i + (lane >> 5)) * A.N + A.n0 + (lane & 31)]);
            if (two) {
#pragma unroll
                for (int i = 0; i < 32; ++i) rb[i] = __builtin_nontemporal_load(&B.W[(size_t)(B.k0 + 2 * i + (lane >> 5)) * B.N + B.n0 + (lane & 31)]);
            }
            p0_store_item(A, ra, scr0, lane);
            if (two) p0_store_item(B, rb, scr1, lane);
        }
        if (reb && bid >= 192) {
            const int gw2 = (bid - 192) * NWAVES + wave;
            for (int it0 = 22528 + gw2; it0 < 24704; it0 += 2 * 512) {
                float ra[32], rb[32]; const bool two = it0 + 512 < 24704; P0Item A = p0_decode(a, it0), B = p0_decode(a, two ? it0 + 512 : it0);
#pragma unroll
                for (int i = 0; i < 32; ++i) ra[i] = __builtin_nontemporal_load(&A.W[(size_t)(A.k0 + 2 * i + (lane >> 5)) * A.N + A.n0 + (lane & 31)]);
                if (two) {
#pragma unroll
                    for (int i = 0; i < 32; ++i) rb[i] = __builtin_nontemporal_load(&B.W[(size_t)(B.k0 + 2 * i + (lane >> 5)) * B.N + B.n0 + (lane & 31)]);
                }
                p0_store_item(A, ra, scr0, lane);
                if (two) p0_store_item(B, rb, scr1, lane);
            }
        }
    }
    const size_t gt = (size_t)bid * NTHR + tid, GT = (size_t)G * NTHR;
    {
        bf16_t* rgw = (bf16_t*)(ws + WS_RGW);
        for (size_t idx = gt; idx < 1179648; idx += GT) {
            const int d = (int)(idx % 96), e = (int)((idx / 96) % 96), hh = (int)((idx / 9216) % 16), mat = (int)((idx / 147456) % 2), dir = (int)((idx / 294912) % 2), i = (int)(idx / 589824);
            float v = 0.f;
            if (d < 88 && e < 88) { const float* src = mat ? a->in[I_RWX] : a->in[I_RWA]; v = src[((size_t)((i * 2 + dir) * 16 + hh) * 88 + d) * 88 + e]; }
            rgw[idx] = (bf16_t)f2bf(v);
        }
    }
    {
        float* hdn = (float*)(ws + WS_HDN);
        const int gw = bid * NWAVES + wave, NGW = G * NWAVES;
        for (int it = gw; it < 2 * NT_ALL; it += NGW) {
            const int i = it / NT_ALL, ta = it % NT_ALL;
            const int L = ta < SEQ ? SEQ : CTXL, pos = ta < SEQ ? ta : ta - SEQ;
            const float tn = (float)pos / (float)(L - 1);
            const float w = (6.283185307179586f * (float)pos) / (float)L;
            float ev = 0.f;
            if (lane == 0) ev = tn;
            else if (lane < 17) { const float f = 1e-4f + (float)(lane - 1) * ((15.0f - 1e-4f) / 15.0f); ev = cosf(f * w); }
            else if (lane < 33) { const float f = 1e-4f + (float)(lane - 17) * ((15.0f - 1e-4f) / 15.0f); ev = -sinf(f * w); }
            float s = a->in[I_F1B][i * 64 + lane];
#pragma unroll
            for (int e = 0; e < 33; ++e) s += __shfl(ev, e) * a->in[I_F1W][(size_t)(i * 33 + e) * 64 + lane];
            const float sf = a->in[I_SINF][i * 64 + lane];
            const float h1 = sinf(sf * s);
            float s2 = a->in[I_F2B][i * 64 + lane];
#pragma unroll 16
            for (int k = 0; k < 64; ++k) s2 += __shfl(h1, k) * a->in[I_F2W][(size_t)(i * 64 + k) * 64 + lane];
            hdn[(size_t)(i * NT_ALL + ta) * 64 + lane] = sinf(sf * s2);
        }
    }
    {
        const f32x4* cs = (const f32x4*)a->in[I_CTX]; u32x2* co = (u32x2*)((bf16_t*)(ws + WS_XS16) + (size_t)ML * D);
        for (size_t i = gt; i < (size_t)MC * D / 4; i += GT) { const f32x4 v = cs[i]; u32x2 w; w.x = pk2(v.x, v.y); w.y = pk2(v.z, v.w); co[i] = w; }
    }
}

__device__ __forceinline__ void xs_load16(const bf16_t* xr, const float* fr, int lane, f32x4 (&v)[4]) {
#pragma unroll
    for (int j = 0; j < 2; ++j) {
        if (fr) { v[2 * j] = *(const f32x4*)(fr + 8 * lane + 512 * j); v[2 * j + 1] = *(const f32x4*)(fr + 8 * lane + 512 * j + 4); }
        else { const u32x4 w = *(const u32x4*)(xr + 8 * lane + 512 * j); v[2 * j] = (f32x4){bflo(w.x), bfhi(w.x), bflo(w.y), bfhi(w.y)}; v[2 * j + 1] = (f32x4){bflo(w.z), bfhi(w.z), bflo(w.w), bfhi(w.w)}; } }
}
__device__ __forceinline__ void xs_raw16(const bf16_t* xr, const float* fr, int lane, u32x4 (&q)[4]) {
    if (fr) {
#pragma unroll
        for (int j = 0; j < 2; ++j) { q[2 * j] = *(const u32x4*)(fr + 8 * lane + 512 * j); q[2 * j + 1] = *(const u32x4*)(fr + 8 * lane + 512 * j + 4); } }
    else { q[0] = *(const u32x4*)(xr + 8 * lane); q[1] = *(const u32x4*)(xr + 8 * lane + 512); }
}
__device__ __forceinline__ void xs_cvt16(const u32x4 (&q)[4], bool isf32, f32x4 (&v)[4]) {
    if (isf32) {
#pragma unroll
        for (int k = 0; k < 4; ++k) v[k] = __builtin_bit_cast(f32x4, q[k]); }
    else {
#pragma unroll
        for (int j = 0; j < 2; ++j) { const u32x4 w = q[j]; v[2 * j] = (f32x4){bflo(w.x), bfhi(w.x), bflo(w.y), bfhi(w.y)}; v[2 * j + 1] = (f32x4){bflo(w.z), bfhi(w.z), bflo(w.w), bfhi(w.w)}; } }
}
__device__ __forceinline__ void phase_norm(KA a, int l, int csh, const float* g, int lane, int gw, int NGW, int nks, const float* gate) {
    const float* mod = (const float*)(a->ws + WS_MOD) + (size_t)l * 5 * NMOD;
    bf16_t* H = (bf16_t*)(a->ws + WS_H); bf16_t* XS = (bf16_t*)(a->ws + WS_XS16);
    const bool l0 = (l == 0 && csh == 0);
    u32x4 qn[4] = {};
    if (gw < MT) xs_raw16(XS + (size_t)gw * D, (l0 && gw < ML) ? a->in[I_X] + (size_t)gw * D : nullptr, lane, qn);
    f32x4 ggv[4], shc[4], scc[4]; int cur_mrow = -1;
#pragma unroll
    for (int q = 0; q < 4; ++q) { ggv[q] = *(const f32x4*)(g + 8 * lane + 512 * (q >> 1) + 4 * (q & 1)); shc[q] = ggv[q]; scc[q] = ggv[q]; }
    for (int row = gw; row < MT; row += NGW) {
        const int mrow = row < ML ? (row >> 12) : 4;
        if (mrow != cur_mrow) { cur_mrow = mrow; const float* shp = mod + mrow * NMOD + csh * 1024 + 8 * lane;
#pragma unroll
            for (int q = 0; q < 4; ++q) { const int off = 512 * (q >> 1) + 4 * (q & 1); shc[q] = *(const f32x4*)(shp + off); scc[q] = *(const f32x4*)(shp + 1024 + off) + 1.0f; } }
        f32x4 v[4]; float s = 0.f;
        u32x4 qc[4];
#pragma unroll
        for (int k = 0; k < 4; ++k) qc[k] = qn[k];
        { const int nr = row + NGW; if (nr < MT) xs_raw16(XS + (size_t)nr * D, (l0 && nr < ML) ? a->in[I_X] + (size_t)nr * D : nullptr, lane, qn); }
        xs_cvt16(qc, l0 && row < ML, v);
        if (row >= ML && nks > 0) {
            const float* pp = (const float*)(a->ws + (csh == 0 ? WS_MIX : WS_HB)) + (size_t)(row - ML) * D + 8 * lane;
            f32x4 ps[4];
#pragma unroll
            for (int q = 0; q < 4; ++q) ps[q] = (f32x4){0.f, 0.f, 0.f, 0.f};
            int ks = 0;
            for (; ks + 4 <= nks; ks += 4) {
                f32x4 t[4][4];
#pragma unroll
                for (int u = 0; u < 4; ++u)
#pragma unroll
                    for (int q = 0; q < 4; ++q) t[u][q] = *(const f32x4*)(pp + (size_t)(ks + u) * MC * D + 512 * (q >> 1) + 4 * (q & 1));
#pragma unroll
                for (int u = 0; u < 4; ++u)
#pragma unroll
                    for (int q = 0; q < 4; ++q) ps[q] += t[u][q];
            }
            for (; ks < nks; ++ks) {
                f32x4 t[4];
#pragma unroll
                for (int q = 0; q < 4; ++q) t[q] = *(const f32x4*)(pp + (size_t)ks * MC * D + 512 * (q >> 1) + 4 * (q & 1));
#pragma unroll
                for (int q = 0; q < 4; ++q) ps[q] += t[q];
            }
#pragma unroll
            for (int q = 0; q < 4; ++q) { const int off = 512 * (q >> 1) + 4 * (q & 1); v[q] += *(const f32x4*)(gate + 4 * NMOD + 8 * lane + off) * ps[q]; }
#pragma unroll
            for (int j = 0; j < 2; ++j) { u32x4 w; w.x = pk2(v[2 * j].x, v[2 * j].y); w.y = pk2(v[2 * j].z, v[2 * j].w); w.z = pk2(v[2 * j + 1].x, v[2 * j + 1].y); w.w = pk2(v[2 * j + 1].z, v[2 * j + 1].w);
                *(u32x4*)(XS + (size_t)row * D + 8 * lane + 512 * j) = w; }
        }
#pragma unroll
        for (int q = 0; q < 4; ++q) s += (v[q].x * v[q].x + v[q].y * v[q].y) + (v[q].z * v[q].z + v[q].w * v[q].w);
        const float rstd = 1.0f / sqrtf(wave_sum(s) * (1.0f / 1024.0f) + EPS);
#pragma unroll
        for (int j = 0; j < 2; ++j) { const int col = 8 * lane + 512 * j; f32x4 o[2];
#pragma unroll
            for (int h = 0; h < 2; ++h) o[h] = (v[2 * j + h] * rstd) * ggv[2 * j + h] * scc[2 * j + h] + shc[2 * j + h];
            u32x4 w; w.x = pk2(o[0].x, o[0].y); w.y = pk2(o[0].z, o[0].w); w.z = pk2(o[1].x, o[1].y); w.w = pk2(o[1].z, o[1].w);
            *(u32x4*)(H + (size_t)row * D + col) = w; }
    }
}
__device__ __forceinline__ void phase_final(KA a, int lane, int gw, int NGW) {
    const float* g = a->in[I_FING]; const bf16_t* XS = (const bf16_t*)(a->ws + WS_XS16);
    u32x4 qn[4] = {};
    if (gw < ML) xs_raw16(XS + (size_t)gw * D, nullptr, lane, qn);
    f32x4 ggv[4];
#pragma unroll
    for (int q = 0; q < 4; ++q) ggv[q] = *(const f32x4*)(g + 8 * lane + 512 * (q >> 1) + 4 * (q & 1));
    for (int row = gw; row < ML; row += NGW) {
        f32x4 v[4]; float s = 0.f;
        u32x4 qc[4];
#pragma unroll
        for (int k = 0; k < 4; ++k) qc[k] = qn[k];
        { const int nr = row + NGW; if (nr < ML) xs_raw16(XS + (size_t)nr * D, nullptr, lane, qn); }
        xs_cvt16(qc, false, v);
#pragma unroll
        for (int q = 0; q < 4; ++q) s += (v[q].x * v[q].x + v[q].y * v[q].y) + (v[q].z * v[q].z + v[q].w * v[q].w);
        const float rstd = 1.0f / sqrtf(wave_sum(s) * (1.0f / 1024.0f) + EPS);
#pragma unroll
        for (int q = 0; q < 4; ++q) { const int col = 8 * lane + 512 * (q >> 1) + 4 * (q & 1); *(f32x4*)(a->out + (size_t)row * D + col) = (v[q] * rstd) * ggv[q]; }
    }
}

__device__ __forceinline__ void kt_tile(KA a, int i, int tile, LAS unsigned char* lds, int tid_) {
    const int tid = mk_opaque_tid();
    const int ti = tile >> 4, ci = tile & 15, ta0 = ti * 128, col0 = ci * 128;
    LAS float* hT = (LAS float*)lds;
    LAS float* fw = (LAS float*)(lds + 34816);
    const float* hdn = (const float*)(a->ws + WS_HDN) + (size_t)i * NT_ALL * 64;
    const float* f3w = a->in[I_F3W] + (size_t)i * 64 * 2048;
    float* KT = (float*)(a->ws + WS_HB);
#pragma unroll
    for (int u = 0; u < 4; ++u) { const int idx = tid + NTHR * u, row = idx >> 4, k4 = idx & 15;
        const f32x4 v = *(const f32x4*)(hdn + (size_t)(ta0 + row) * 64 + 4 * k4);
        hT[(4 * k4 + 0) * 132 + row] = v.x; hT[(4 * k4 + 1) * 132 + row] = v.y; hT[(4 * k4 + 2) * 132 + row] = v.z; hT[(4 * k4 + 3) * 132 + row] = v.w;
        const int k = idx >> 5, c4 = idx & 31;
        *(LAS f32x4*)(fw + k * 128 + 4 * c4) = *(const f32x4*)(f3w + (size_t)k * 2048 + col0 + 4 * c4); }
    __syncthreads();
    const int tx = tid & 31, ty = tid >> 5;
    f32x4 acc[8];
#pragma unroll
    for (int cc = 0; cc < 8; ++cc) acc[cc] = (f32x4){0.f, 0.f, 0.f, 0.f};
#pragma unroll 4
    for (int k = 0; k < 64; ++k) {
        const f32x4 hv = *(const LAS f32x4*)(hT + k * 132 + 4 * tx);
        const f32x4 w0 = *(const LAS f32x4*)(fw + k * 128 + 8 * ty), w1 = *(const LAS f32x4*)(fw + k * 128 + 8 * ty + 4);
        acc[0] += w0.x * hv; acc[1] += w0.y * hv; acc[2] += w0.z * hv; acc[3] += w0.w * hv;
        acc[4] += w1.x * hv; acc[5] += w1.y * hv; acc[6] += w1.z * hv; acc[7] += w1.w * hv;
    }
#pragma unroll
    for (int cc = 0; cc < 8; ++cc) { const int col = col0 + 8 * ty + cc; const float bb = a->in[I_F3B][i * 2048 + col];
        *(f32x4*)(KT + (size_t)col * NT_ALL + ta0 + 4 * tx) = acc[cc] + bb; }
    __syncthreads();
}

template <bool INV> __device__ __forceinline__ f32x2 mul_w16(f32x2 v, int e) {
    float c, s;
    switch (e) { case 1: c = 0.92387953251f; s = 0.38268343237f; break; case 2: c = 0.70710678119f; s = 0.70710678119f; break; case 3: c = 0.38268343237f; s = 0.92387953251f; break;
                 case 6: c = -0.70710678119f; s = 0.70710678119f; break; case 9: c = -0.92387953251f; s = -0.38268343237f; break; default: c = 1.f; s = 0.f; break; }
    if (e == 0) return v;
    if (e == 4) return INV ? (f32x2){-v.y, v.x} : (f32x2){v.y, -v.x};
    return INV ? (f32x2){v.x * c - v.y * s, v.y * c + v.x * s} : (f32x2){v.x * c + v.y * s, v.y * c - v.x * s};
}
template <bool INV> __device__ __forceinline__ void dft4(f32x2& a, f32x2& b, f32x2& c, f32x2& d) {
    const f32x2 s0 = a + c, d0 = a - c, s1 = b + d, d1 = b - d;
    const f32x2 r = INV ? (f32x2){-d1.y, d1.x} : (f32x2){d1.y, -d1.x};
    a = s0 + s1; c = s0 - s1; b = d0 + r; d = d0 - r;
}
template <bool INV> __device__ __forceinline__ void dft16(f32x2 (&v)[16]) {
#pragma unroll
    for (int n2 = 0; n2 < 4; ++n2) dft4<INV>(v[n2], v[4 + n2], v[8 + n2], v[12 + n2]);
#pragma unroll
    for (int n2 = 1; n2 < 4; ++n2)
#pragma unroll
        for (int k1 = 1; k1 < 4; ++k1) v[4 * k1 + n2] = mul_w16<INV>(v[4 * k1 + n2], n2 * k1);
#pragma unroll
    for (int k1 = 0; k1 < 4; ++k1) dft4<INV>(v[4 * k1 + 0], v[4 * k1 + 1], v[4 * k1 + 2], v[4 * k1 + 3]);
#pragma unroll
    for (int x = 0; x < 4; ++x)
#pragma unroll
        for (int y = x + 1; y < 4; ++y) { const f32x2 t = v[4 * x + y]; v[4 * x + y] = v[4 * y + x]; v[4 * y + x] = t; }
}
__device__ __forceinline__ int fphys(int idx) { return idx + (idx >> 4); }
template <bool INV, int LGM, bool MUL = false, bool WAVE_LOCAL = false> __device__ __forceinline__ void r16_pass(LAS f32x2* buf, int tid_, const LAS f32x2* kbuf = nullptr, float kscale = 0.f) {
    const int tid = mk_opaque_tid();
    constexpr int LGS = LGM - 4, S = 1 << LGS, PST = S >= 16 ? S + S / 16 : 1;
    {
        const int half = tid >> 8, tp = tid & 255;
        const int blk = tp >> LGS, p = tp & (S - 1);
        const int base = (half << 12) + (blk << LGM) + p;
        LAS f32x2* bp = buf + fphys(base);
        const float angp = (float)p / (float)(1 << LGM);
        f32x2 v[16];
#pragma unroll
        for (int j = 0; j < 16; ++j) v[j] = bp[j * PST];
        if (INV && LGS > 0) {
            { const float c1 = __builtin_amdgcn_cosf(angp), s1 = __builtin_amdgcn_sinf(angp); float c = c1, s = s1;
#pragma unroll
              for (int r = 1; r < 16; ++r) { v[r] = (f32x2){v[r].x * c - v[r].y * s, v[r].y * c + v[r].x * s};
                  if ((r & 3) == 3) { const float an = angp * (float)(r + 1); c = __builtin_amdgcn_cosf(an); s = __builtin_amdgcn_sinf(an); } else { const float cn = c * c1 - s * s1; s = s * c1 + c * s1; c = cn; } } }
        }
        dft16<INV>(v);
        if (!INV && LGS > 0) {
            { const float c1 = __builtin_amdgcn_cosf(angp), s1 = __builtin_amdgcn_sinf(angp); float c = c1, s = s1;
#pragma unroll
              for (int r = 1; r < 16; ++r) { v[r] = (f32x2){v[r].x * c + v[r].y * s, v[r].y * c - v[r].x * s};
                  if ((r & 3) == 3) { const float an = angp * (float)(r + 1); c = __builtin_amdgcn_cosf(an); s = __builtin_amdgcn_sinf(an); } else { const float cn = c * c1 - s * s1; s = s * c1 + c * s1; c = cn; } } }
        }
        if (MUL) { const LAS f32x2* kp = kbuf + fphys(base);
#pragma unroll
            for (int j = 0; j < 16; ++j) { const f32x2 k = kp[j * PST], x = v[j]; v[j] = (f32x2){(x.x * k.x - x.y * k.y) * kscale, (x.x * k.y + x.y * k.x) * kscale}; } }
#pragma unroll
        for (int j = 0; j < 16; ++j) bp[j * PST] = v[j];
    }
    if (WAVE_LOCAL) asm volatile("s_waitcnt lgkmcnt(0)" ::: "memory"); else __syncthreads();
}
template <bool INV, bool MUL = false> __device__ __forceinline__ void fft8192(LAS f32x2* buf, int tid, const LAS f32x2* kbuf = nullptr, float kscale = 0.f) {
    if (!INV) { r16_pass<false, 12>(buf, tid); r16_pass<false, 8, false, true>(buf, tid); r16_pass<false, 4, MUL>(buf, tid, kbuf, kscale); }
    else { r16_pass<true, 4, false, true>(buf, tid); r16_pass<true, 8>(buf, tid); r16_pass<true, 12>(buf, tid); }
}
__device__ __forceinline__ float conv3(const bf16_t* z, int n, int L, float w0, float w1, float w2, float b) {
    float r = b + w1 * bf2f(z[n]);
    if (n > 0) r += w0 * bf2f(z[n - 1]);
    if (n < L - 1) r += w2 * bf2f(z[n + 1]);
    return r;
}
__device__ __forceinline__ void conv3x8(const bf16_t* z, int n0, int L, float w0, float w1, float w2, float b, float (&o)[8]) {
    const u32x4 w = *(const u32x4*)(z + n0);
    float x[10];
    x[0] = n0 > 0 ? bf2f(z[n0 - 1]) : 0.f; x[9] = n0 + 8 < L ? bf2f(z[n0 + 8]) : 0.f;
    x[1] = bflo(w.x); x[2] = bfhi(w.x); x[3] = bflo(w.y); x[4] = bfhi(w.y); x[5] = bflo(w.z); x[6] = bfhi(w.z); x[7] = bflo(w.w); x[8] = bfhi(w.w);
#pragma unroll
    for (int e = 0; e < 8; ++e) o[e] = b + w0 * x[e] + w1 * x[e + 1] + w2 * x[e + 2];
}
struct Raw8 { u32x4 w; unsigned l, r; };
__device__ __forceinline__ Raw8 raw8_load(const bf16_t* z, int n0, int L) { Raw8 q; q.w = *(const u32x4*)(z + n0); q.l = n0 > 0 ? (unsigned)z[n0 - 1] : 0u; q.r = n0 + 8 < L ? (unsigned)z[n0 + 8] : 0u; return q; }
__device__ __forceinline__ void conv3_raw(const Raw8& q, float w0, float w1, float w2, float b, float (&o)[8]) {
    float x[10];
    x[0] = bf2f(q.l); x[9] = bf2f(q.r);
    x[1] = bflo(q.w.x); x[2] = bfhi(q.w.x); x[3] = bflo(q.w.y); x[4] = bfhi(q.w.y); x[5] = bflo(q.w.z); x[6] = bfhi(q.w.z); x[7] = bflo(q.w.w); x[8] = bfhi(q.w.w);
#pragma unroll
    for (int e = 0; e < 8; ++e) o[e] = b + w0 * x[e] + w1 * x[e + 1] + w2 * x[e + 2];
}
constexpr int FBUF_BYTES = 8704 * 8;
__device__ __forceinline__ void hyena_item(KA a, int i, int c, LAS unsigned char* lds, int tid_, int lane_, int wave_) {
    const int tid = mk_opaque_tid(), lane = tid & 63, wave = __builtin_amdgcn_readfirstlane(tid >> 6);
    LAS f32x2* bufA = (LAS f32x2*)lds; LAS f32x2* bufB = (LAS f32x2*)(lds + FBUF_BYTES);
    LAS float* red = (LAS float*)(lds + 2 * FBUF_BYTES);
    const bf16_t* ZT = (const bf16_t*)(a->ws + WS_Z);
    float* YT = (float*)(a->ws + WS_H);
    bf16_t* MIX = (bf16_t*)(a->ws + WS_MIX);
    const float* KT = (const float*)(a->ws + WS_HB);
    const float* cw = a->in[I_HCW] + (size_t)i * 3 * 1536; const float* cb = a->in[I_HCB] + (size_t)i * 1536;
    const float la = -3.0701134573253945f, lb = -15.350567286626973f;
    const float delta = fabsf(la + (float)c * ((lb - la) / 511.0f));
    const float vw0 = cw[c], vw1 = cw[1536 + c], vw2 = cw[3072 + c], vb = cb[c];
#pragma unroll 1
    for (int o = 0; o < 2; ++o) {
        const float skip = a->in[I_SKIP][(i * 2 + o) * 512 + c];
        const int chg = (o + 1) * 512 + c;
        const float gw0 = cw[chg], gw1 = cw[1536 + chg], gw2 = cw[3072 + chg], gb = cb[chg];
        {
            int L = SEQ; asm volatile("" : "+s"(L));
            const int N = 2 * L, toff = 0, tokbase = 0;
            const int nact = L >> 3;
            const int n0 = tid * 8;
            const float invN = 1.0f / (float)N;
            float ssq = 0.f;
            if (tid < nact) {
                const float* k0p = KT + (size_t)((o * 2 + 0) * 512 + c) * NT_ALL + toff; const float* k1p = KT + (size_t)((o * 2 + 1) * 512 + c) * NT_ALL + toff;
                const float tscale = delta / (float)(L - 1);
                const f32x4 h0 = *(const f32x4*)(k0p + n0), h1 = *(const f32x4*)(k0p + n0 + 4);
                const float hh0[8] = {h0.x, h0.y, h0.z, h0.w, h1.x, h1.y, h1.z, h1.w};
#pragma unroll
                for (int e = 0; e < 8; ++e) { const int n = n0 + e;
                    const float ka = hh0[e] * __expf(-(float)n * tscale);
                    const float kb = n > 0 ? k1p[L - n] * __expf(-(float)(L - n) * tscale) : 0.f;
                    ssq += ka * ka + kb * kb;
                    const float ang = (float)n * invN, cs = __builtin_amdgcn_cosf(ang), sn = __builtin_amdgcn_sinf(ang), df = ka - kb;
                    bufA[fphys(n)] = (f32x2){ka + kb, 0.f};
                    bufA[fphys(n + L)] = (f32x2){df * cs, -df * sn}; }
            }
            ssq = wave_sum(ssq);
            if (lane == 0) red[wave] = ssq;
            __syncthreads();
            float tot = 0.f;
#pragma unroll
            for (int w = 0; w < NWAVES; ++w) tot += red[w];
            const float scale = (1.0f / sqrtf(tot + EPS)) * invN;
            fft8192<false>(bufA, tid);
#pragma unroll 1
            for (int pair = 0; pair < 2; ++pair) {
                const int tok0 = tokbase + (2 * pair) * L, tok1 = tok0 + L;
                const bf16_t* zv0 = ZT + (size_t)c * MT + tok0; const bf16_t* zv1 = ZT + (size_t)c * MT + tok1;
                const bf16_t* zg0 = ZT + (size_t)chg * MT + tok0; const bf16_t* zg1 = ZT + (size_t)chg * MT + tok1;
                float* y0p = YT + (size_t)c * MT + tok0; float* y1p = YT + (size_t)c * MT + tok1;
                float x0[8], x1[8]; Raw8 gq0, gq1;
                if (tid < nact) {
                    if (o == 0) { conv3x8(zv0, n0, L, vw0, vw1, vw2, vb, x0); conv3x8(zv1, n0, L, vw0, vw1, vw2, vb, x1); }
                    else { const f32x4 a0 = *(const f32x4*)(y0p + n0), a1 = *(const f32x4*)(y0p + n0 + 4), b0 = *(const f32x4*)(y1p + n0), b1 = *(const f32x4*)(y1p + n0 + 4);
                        x0[0] = a0.x; x0[1] = a0.y; x0[2] = a0.z; x0[3] = a0.w; x0[4] = a1.x; x0[5] = a1.y; x0[6] = a1.z; x0[7] = a1.w;
                        x1[0] = b0.x; x1[1] = b0.y; x1[2] = b0.z; x1[3] = b0.w; x1[4] = b1.x; x1[5] = b1.y; x1[6] = b1.z; x1[7] = b1.w; }
#pragma unroll
                    for (int e = 0; e < 8; ++e) { const int n = n0 + e; const float ang = (float)n * invN, cs = __builtin_amdgcn_cosf(ang), sn = __builtin_amdgcn_sinf(ang);
                        bufB[fphys(n)] = (f32x2){x0[e], x1[e]};
                        bufB[fphys(n + L)] = (f32x2){x0[e] * cs + x1[e] * sn, x1[e] * cs - x0[e] * sn}; }
                    gq0 = raw8_load(zg0, n0, L); gq1 = raw8_load(zg1, n0, L);
                }
                __syncthreads();
                fft8192<false, true>(bufB, tid, bufA, scale);
                fft8192<true>(bufB, tid);
                if (tid < nact) {
                    float g0[8], g1[8], lc0[8], lc1[8];
                    conv3_raw(gq0, gw0, gw1, gw2, gb, g0); conv3_raw(gq1, gw0, gw1, gw2, gb, g1);
#pragma unroll
                    for (int e = 0; e < 8; ++e) { const int n = n0 + e; const float ang = (float)n * invN, cs = __builtin_amdgcn_cosf(ang), sn = __builtin_amdgcn_sinf(ang);
                        const f32x2 u = bufB[fphys(n)], v = bufB[fphys(n + L)];
                        lc0[e] = u.x + (v.x * cs - v.y * sn); lc1[e] = u.y + (v.y * cs + v.x * sn); }
                    if (o == 0) {
                        const float (&v0)[8] = x0; const float (&v1)[8] = x1;
                        f32x4 r0, r1, s0, s1;
                        r0.x = g0[0] * (lc0[0] + skip * v0[0]); r0.y = g0[1] * (lc0[1] + skip * v0[1]); r0.z = g0[2] * (lc0[2] + skip * v0[2]); r0.w = g0[3] * (lc0[3] + skip * v0[3]);
                        r1.x = g0[4] * (lc0[4] + skip * v0[4]); r1.y = g0[5] * (lc0[5] + skip * v0[5]); r1.z = g0[6] * (lc0[6] + skip * v0[6]); r1.w = g0[7] * (lc0[7] + skip * v0[7]);
                        s0.x = g1[0] * (lc1[0] + skip * v1[0]); s0.y = g1[1] * (lc1[1] + skip * v1[1]); s0.z = g1[2] * (lc1[2] + skip * v1[2]); s0.w = g1[3] * (lc1[3] + skip * v1[3]);
                        s1.x = g1[4] * (lc1[4] + skip * v1[4]); s1.y = g1[5] * (lc1[5] + skip * v1[5]); s1.z = g1[6] * (lc1[6] + skip * v1[6]); s1.w = g1[7] * (lc1[7] + skip * v1[7]);
                        *(f32x4*)(y0p + n0) = r0; *(f32x4*)(y0p + n0 + 4) = r1; *(f32x4*)(y1p + n0) = s0; *(f32x4*)(y1p + n0 + 4) = s1;
                    } else {
                        const float (&v0)[8] = x0; const float (&v1)[8] = x1;
#pragma unroll
                        for (int e = 0; e < 8; ++e) {
                            MIX[(size_t)(tok0 + n0 + e) * D + c] = (bf16_t)f2bf(g0[e] * (lc0[e] + skip * v0[e]));
                            MIX[(size_t)(tok1 + n0 + e) * D + c] = (bf16_t)f2bf(g1[e] * (lc1[e] + skip * v1[e])); }
                    }
                }
                __syncthreads();
            }
        }
    }
    {
        LAS float* kf = (LAS float*)lds;
        LAS float* vbuf = (LAS float*)(lds + 4096);
        LAS float* ybuf = (LAS float*)(lds + 8192);
        const int t = tid & 255, bp = tid >> 8;
#pragma unroll 1
        for (int o = 0; o < 2; ++o) {
            const float skip = a->in[I_SKIP][(i * 2 + o) * 512 + c];
            const int chg = (o + 1) * 512 + c;
            const float gw0 = cw[chg], gw1 = cw[1536 + chg], gw2 = cw[3072 + chg], gb = cb[chg];
            float ssq = 0.f;
            if (tid < 256) {
                const float tscale = delta / (float)(CTXL - 1);
                const float dec = __expf(-(float)tid * tscale);
                const float k0 = KT[(size_t)((o * 2 + 0) * 512 + c) * NT_ALL + SEQ + tid] * dec;
                kf[255 + tid] = k0; ssq = k0 * k0;
                if (tid > 0) { const float k1 = KT[(size_t)((o * 2 + 1) * 512 + c) * NT_ALL + SEQ + tid] * dec; kf[255 - tid] = k1; ssq += k1 * k1; }
            }
            for (int e = tid; e < 1024; e += NTHR) { const int bb = e >> 8, tt = e & 255;
                if (o == 0) vbuf[e] = conv3(ZT + (size_t)c * MT + ML + bb * CTXL, tt, CTXL, vw0, vw1, vw2, vb); else vbuf[e] = ybuf[e]; }
            ssq = wave_sum(ssq);
            if (lane == 0) red[wave] = ssq;
            __syncthreads();
            float tot = 0.f;
#pragma unroll
            for (int w = 0; w < NWAVES; ++w) tot += red[w];
            const float scale = 1.0f / sqrtf(tot + EPS);
            float a0 = 0.f, a1 = 0.f;
            const LAS float* v0p = vbuf + (2 * bp) * 256; const LAS float* v1p = v0p + 256; const LAS float* kp = kf + 255 + t;
#pragma unroll 8
            for (int s = 0; s < 256; ++s) { const float kk = kp[-s]; a0 += kk * v0p[s]; a1 += kk * v1p[s]; }
            const int b0 = 2 * bp, b1 = b0 + 1;
            const float g0 = conv3(ZT + (size_t)chg * MT + ML + b0 * CTXL, t, CTXL, gw0, gw1, gw2, gb), g1 = conv3(ZT + (size_t)chg * MT + ML + b1 * CTXL, t, CTXL, gw0, gw1, gw2, gb);
            const float r0 = g0 * (a0 * scale + skip * v0p[t]), r1 = g1 * (a1 * scale + skip * v1p[t]);
            __syncthreads();
            if (o == 0) { ybuf[b0 * 256 + t] = r0; ybuf[b1 * 256 + t] = r1; }
            else { MIX[(size_t)(ML + b0 * CTXL + t) * D + c] = (bf16_t)f2bf(r0); MIX[(size_t)(ML + b1 * CTXL + t) * D + c] = (bf16_t)f2bf(r1); }
            __syncthreads();
        }
    }
}
__device__ __forceinline__ void sgu_item(KA a, int i, int item, LAS unsigned char* lds, int tid_) {
    const int tid = mk_opaque_tid();
    const int chunk = item >> 2, g = item & 3, tok0 = chunk * 128;
    const bf16_t* ZB = (const bf16_t*)(a->ws + WS_Z) + (size_t)1536 * MT;
    bf16_t* MIX = (bf16_t*)(a->ws + WS_MIX);
    LAS float* Wl = (LAS float*)lds; LAS float* Vl = (LAS float*)(lds + 65536); LAS float* st = (LAS float*)(lds + 131072);
    const float* Wg = a->in[I_SGUW] + (size_t)(i * 4 + g) * 16384;
    f32x4 wraw[4][2]; u32x4 vraw[4];
#pragma unroll
    for (int u = 0; u < 4; ++u) { const int idx = tid + NTHR * u, p = idx >> 4, q0 = (idx & 15) * 8;
        wraw[u][0] = *(const f32x4*)(Wg + p * 128 + q0); wraw[u][1] = *(const f32x4*)(Wg + p * 128 + q0 + 4);
        vraw[u] = *(const u32x4*)(ZB + (size_t)(tok0 + p) * D + 512 + g * 128 + q0); }
    {
        const int t = tid >> 2, part = tid & 3; const bf16_t* p = ZB + (size_t)(tok0 + t) * D + 512 + part * 128;
        float s = 0.f, ss = 0.f;
#pragma unroll
        for (int v = 0; v < 16; ++v) { const u32x4 w = *(const u32x4*)(p + 8 * v);
#pragma unroll
            for (int j = 0; j < 4; ++j) { const float x0 = bflo(w[j]), x1 = bfhi(w[j]); s += x0 + x1; ss += x0 * x0 + x1 * x1; } }
        s += __shfl_xor(s, 1); s += __shfl_xor(s, 2); ss += __shfl_xor(ss, 1); ss += __shfl_xor(ss, 2);
        const float mean = s * (1.0f / 512.0f), var = fmaxf(ss * (1.0f / 512.0f) - mean * mean, 0.f);
        if (part == 0) { st[t] = mean; st[128 + t] = 1.0f / sqrtf(var + EPS); }
    }
    LAS bf16_t* Wb = (LAS bf16_t*)lds; LAS bf16_t* VT = (LAS bf16_t*)(lds + 34816);
#pragma unroll
    for (int u = 0; u < 4; ++u) { const int idx = tid + NTHR * u, p = idx >> 4, q0 = (idx & 15) * 8;
        const f32x4 w0 = wraw[u][0], w1 = wraw[u][1];
        u32x4 pk; pk.x = pk2(w0.x, w0.y); pk.y = pk2(w0.z, w0.w); pk.z = pk2(w1.x, w1.y); pk.w = pk2(w1.z, w1.w);
        *(LAS u32x4*)(Wb + p * 136 + q0) = pk; }
    __syncthreads();
    const float* lng = a->in[I_LNG] + i * 512 + g * 128;
#pragma unroll
    for (int u = 0; u < 4; ++u) { const int vv = tid + NTHR * u, q = vv >> 4, d0 = (vv & 15) * 8;
        const u32x4 w = vraw[u];
        const float m = st[q], r = st[128 + q];
        const f32x4 l0 = *(const f32x4*)(lng + d0), l1 = *(const f32x4*)(lng + d0 + 4);
        float o[8];
        o[0] = (bflo(w.x) - m) * r * l0.x; o[1] = (bfhi(w.x) - m) * r * l0.y; o[2] = (bflo(w.y) - m) * r * l0.z; o[3] = (bfhi(w.y) - m) * r * l0.w;
        o[4] = (bflo(w.z) - m) * r * l1.x; o[5] = (bfhi(w.z) - m) * r * l1.y; o[6] = (bflo(w.w) - m) * r * l1.z; o[7] = (bfhi(w.w) - m) * r * l1.w;
#pragma unroll
        for (int j = 0; j < 8; ++j) VT[(d0 + j) * 136 + q] = (bf16_t)f2bf(o[j]); }
    __syncthreads();
    {
        const int lane = tid & 63, wv = tid >> 6, tk = lane & 15, kq = lane >> 4;
        bf16x8 af[4];
#pragma unroll
        for (int ks = 0; ks < 4; ++ks) af[ks] = *(const LAS bf16x8*)(VT + (16 * wv + tk) * 136 + 32 * ks + 8 * kq);
#pragma unroll 2
        for (int nt = 0; nt < 8; ++nt) {
            f32x4 acc = (f32x4){0.f, 0.f, 0.f, 0.f};
#pragma unroll
            for (int ks = 0; ks < 4; ++ks) { const bf16x8 bfr = *(const LAS bf16x8*)(Wb + (16 * nt + tk) * 136 + 32 * ks + 8 * kq); acc = __builtin_amdgcn_mfma_f32_16x16x32_bf16(af[ks], bfr, acc, 0, 0, 0); }
            const int p = 16 * nt + tk, tok = tok0 + p, d0 = 16 * wv + 4 * kq;
            const float bias = a->in[I_SGUB][(i * 4 + g) * 128 + p];
            const u32x2 uw = *(const u32x2*)(ZB + (size_t)tok * D + g * 128 + d0);
            u32x2 w; w.x = pk2(bflo(uw.x) * (acc.x + bias), bfhi(uw.x) * (acc.y + bias)); w.y = pk2(bflo(uw.y) * (acc.z + bias), bfhi(uw.y) * (acc.w + bias));
            *(u32x2*)(MIX + (size_t)tok * D + 512 + g * 128 + d0) = w;
        }
    }
    __syncthreads();
}

template <int S> __device__ __forceinline__ float dpp_row_shr(float v, float ident) {
    return __builtin_bit_cast(float, __builtin_amdgcn_update_dpp(__builtin_bit_cast(int, ident), __builtin_bit_cast(int, v), 0x110 + S, 0xf, 0xf, false));
}
__device__ __forceinline__ int rg_pos(int S, int wave, int tk, int dir, int& Lq) {
    const bool isctx = S < 2; const int sl = (isctx ? 0 : (S >> 1) - 1) * 256 + wave * 32 + (S & 1) * 16 + tk; Lq = isctx ? CTXL : SEQ; return dir ? (Lq - 1 - sl) : sl;
}
__device__ __forceinline__ int rg_row(int S, int b, int pp, bool colmajor) { return S < 2 ? (ML + b * CTXL + pp) : (b * SEQ + (colmajor ? (((pp & 63) << 6) + (pp >> 6)) : pp)); }
__device__ __forceinline__ void rg_issue(const bf16_t* Zx, int S, int wave, int tk, int kq, int dir, int b, bool colmajor, u32x4 (&pre)[12]) {
    int Lq; const int p = rg_pos(S, wave, tk, dir, Lq);
#pragma unroll
    for (int k = 0; k < 4; ++k) { int pp = p + k - 2; pp = pp < 0 ? 0 : (pp > Lq - 1 ? Lq - 1 : pp);
        const bf16_t* rp = Zx + (size_t)rg_row(S, b, pp, colmajor) * NOIN;
#pragma unroll
        for (int ks = 0; ks < 3; ++ks) { int d0 = 32 * ks + 8 * kq; d0 = d0 > 80 ? 80 : d0; pre[k * 3 + ks] = *(const u32x4*)(rp + d0); } }
}
__device__ __forceinline__ void rglru_item(KA a, int i, bool colmajor, int item, LAS unsigned char* lds) {
    const int tid = mk_opaque_tid(), lane = tid & 63, wave = __builtin_amdgcn_readfirstlane(tid >> 6);
    const int half = item & 1, dir = (item >> 1) & 1, hh = (item >> 2) & 15, b = item >> 6;
    const int ebase = half ? 40 : 0;
    LAS unsigned char* WAl = lds; LAS unsigned char* WXl = lds + 18432;
    LAS float* tab = (LAS float*)(lds + 36864);
    LAS float* xsw = (LAS float*)(lds + 40960) + wave * 1600;
    LAS float* agg = (LAS float*)(lds + 92160);
    LAS int* flg = (LAS int*)(lds + 92160 + 8192);
    LAS float* t0a = (LAS float*)(lds + 92160 + 8192 + 256) + wave * 192;
    const bf16_t* Zx = (const bf16_t*)(a->ws + WS_Z) + DRNN + hh * 88;
    bf16_t* HO = (bf16_t*)(a->ws + (dir ? WS_HB : WS_MIX));
    u32x4 pre[12];
    if (RG_PREFETCH) rg_issue(Zx, 0, wave, lane & 15, lane >> 4, dir, b, colmajor, pre);
    {
        const u32x4* src = (const u32x4*)((const bf16_t*)(a->ws + WS_RGW) + (size_t)(((i * 2 + dir) * 2 + 0) * 16 + hh) * 9216);
        const u32x4* srx = (const u32x4*)((const bf16_t*)(a->ws + WS_RGW) + (size_t)(((i * 2 + dir) * 2 + 1) * 16 + hh) * 9216);
        for (int v = tid; v < 1152; v += NTHR) { *(LAS u32x4*)(WAl + 16 * v) = src[v]; *(LAS u32x4*)(WXl + 16 * v) = srx[v]; }
        if (tid < 96) { const int e = tid, ch = hh * 88 + (e < 88 ? e : 87); const int pd = (i * 2 + dir) * DRNN + ch;
#pragma unroll
            for (int k = 0; k < 4; ++k) tab[k * 96 + e] = a->in[I_RCW][(size_t)(i * 4 + k) * DRNN + ch];
            tab[384 + e] = a->in[I_RCB][i * DRNN + ch]; tab[480 + e] = a->in[I_RBA][pd]; tab[576 + e] = a->in[I_RBX][pd];
            tab[672 + e] = -8.0f * 1.4426950408889634f * log1pf(expf(-a->in[I_LAM][pd])); }
        if (tid < 8) flg[tid] = 0;
    }
    __syncthreads();
    const int tk = lane & 15, kq = lane >> 4;
    bf16x8 FA[3][3], FX[3][3];
#pragma unroll
    for (int mt = 0; mt < 3; ++mt)
#pragma unroll
        for (int ks = 0; ks < 3; ++ks) { FA[mt][ks] = *(const LAS bf16x8*)(WAl + (ebase + 16 * mt + tk) * 192 + (32 * ks + 8 * kq) * 2); FX[mt][ks] = *(const LAS bf16x8*)(WXl + (ebase + 16 * mt + tk) * 192 + (32 * ks + 8 * kq) * 2); }
    f32x4 Ac0[3], Bc0[3]; int p_t0 = 0;
#pragma unroll
    for (int mt = 0; mt < 3; ++mt) { Ac0[mt] = (f32x4){0.f, 0.f, 0.f, 0.f}; Bc0[mt] = Ac0[mt]; }
#pragma unroll 1
    for (int S = 0; S < 34; ++S) {
        int Lq; const int p = rg_pos(S, wave, tk, dir, Lq);
        if (!RG_PREFETCH) rg_issue(Zx, S, wave, tk, kq, dir, b, colmajor, pre);
        bf16x8 Bf[3];
#pragma unroll
        for (int ks = 0; ks < 3; ++ks) {
            const int d0 = 32 * ks + 8 * kq;
            if (d0 < 88) {
                f32x4 x0 = *(const LAS f32x4*)(tab + 384 + d0), x1 = *(const LAS f32x4*)(tab + 384 + d0 + 4);
#pragma unroll
                for (int k = 0; k < 4; ++k) { const int pp = p + k - 2;
                    if (pp >= 0 && pp < Lq) {
                        const u32x4 w = pre[k * 3 + ks];
                        const f32x4 c0 = *(const LAS f32x4*)(tab + k * 96 + d0), c1 = *(const LAS f32x4*)(tab + k * 96 + d0 + 4);
                        x0.x += c0.x * bflo(w.x); x0.y += c0.y * bfhi(w.x); x0.z += c0.z * bflo(w.y); x0.w += c0.w * bfhi(w.y);
                        x1.x += c1.x * bflo(w.z); x1.y += c1.y * bfhi(w.z); x1.z += c1.z * bflo(w.w); x1.w += c1.w * bfhi(w.w); } }
                *(LAS f32x4*)(xsw + tk * 100 + d0) = x0; *(LAS f32x4*)(xsw + tk * 100 + d0 + 4) = x1;
                u32x4 pk; pk.x = pk2(x0.x, x0.y); pk.y = pk2(x0.z, x0.w); pk.z = pk2(x1.x, x1.y); pk.w = pk2(x1.z, x1.w);
                Bf[ks] = __builtin_bit_cast(bf16x8, pk);
            } else Bf[ks] = (bf16x8){0, 0, 0, 0, 0, 0, 0, 0};
        }
        if (RG_PREFETCH && S + 1 < 34) rg_issue(Zx, S + 1, wave, tk, kq, dir, b, colmajor, pre);
        asm volatile("s_waitcnt lgkmcnt(0)" ::: "memory");
        f32x4 Ac[3], Bc[3];
#pragma unroll
        for (int mt = 0; mt < 3; ++mt) {
            const int e0 = ebase + 16 * mt;
            f32x4 ca = (f32x4){0.f, 0.f, 0.f, 0.f}, cx = ca;
#pragma unroll
            for (int ks = 0; ks < 3; ++ks) {
                ca = __builtin_amdgcn_mfma_f32_16x16x32_bf16(FA[mt][ks], Bf[ks], ca, 0, 0, 0);
                cx = __builtin_amdgcn_mfma_f32_16x16x32_bf16(FX[mt][ks], Bf[ks], cx, 0, 0, 0);
            }
            const int eb = e0 + 4 * kq;
            const f32x4 ba4 = *(const LAS f32x4*)(tab + 480 + eb), bx4 = *(const LAS f32x4*)(tab + 576 + eb), sp4 = *(const LAS f32x4*)(tab + 672 + eb);
            const f32x4 xe = *(const LAS f32x4*)(xsw + tk * 100 + eb);
            f32x4 Aj, Bj;
#pragma unroll
            for (int j = 0; j < 4; ++j) {
                const float r = sigmoidf_(ca[j] + ba4[j]), gi = sigmoidf_(cx[j] + bx4[j]);
                const float av = __builtin_amdgcn_exp2f(r * sp4[j]);
                Aj[j] = av; Bj[j] = __builtin_amdgcn_sqrtf(fmaxf(1.0f - av * av, 0.f)) * gi * xe[j];
            }
            {
                float a0 = Aj[0], a1 = Aj[1], a2 = Aj[2], a3 = Aj[3], b0 = Bj[0], b1 = Bj[1], b2 = Bj[2], b3 = Bj[3];
#define RG_STEP(SH) asm volatile("s_nop 1\n\t" \
                "v_fmac_f32_dpp %0, %0, %4 row_shr:" #SH " row_mask:0xf bank_mask:0xf\n\tv_mul_f32_dpp %4, %4, %4 row_shr:" #SH " row_mask:0xf bank_mask:0xf\n\t" \
                "v_fmac_f32_dpp %1, %1, %5 row_shr:" #SH " row_mask:0xf bank_mask:0xf\n\tv_mul_f32_dpp %5, %5, %5 row_shr:" #SH " row_mask:0xf bank_mask:0xf\n\t" \
                "v_fmac_f32_dpp %2, %2, %6 row_shr:" #SH " row_mask:0xf bank_mask:0xf\n\tv_mul_f32_dpp %6, %6, %6 row_shr:" #SH " row_mask:0xf bank_mask:0xf\n\t" \
                "v_fmac_f32_dpp %3, %3, %7 row_shr:" #SH " row_mask:0xf bank_mask:0xf\n\tv_mul_f32_dpp %7, %7, %7 row_shr:" #SH " row_mask:0xf bank_mask:0xf\n\ts_nop 1" \
                : "+v"(b0), "+v"(b1), "+v"(b2), "+v"(b3), "+v"(a0), "+v"(a1), "+v"(a2), "+v"(a3));
                RG_STEP(1) RG_STEP(2) RG_STEP(4) RG_STEP(8)
                Aj = (f32x4){a0, a1, a2, a3}; Bj = (f32x4){b0, b1, b2, b3};
            }
#undef RG_STEP
            Ac[mt] = Aj; Bc[mt] = Bj;
        }
        if ((S & 1) == 0) {
#pragma unroll
            for (int mt = 0; mt < 3; ++mt) { Ac0[mt] = Ac[mt]; Bc0[mt] = Bc[mt]; }
            p_t0 = p;
            if (tk == 15) {
#pragma unroll
                for (int mt = 0; mt < 3; ++mt) { *(LAS f32x4*)(t0a + ebase + 16 * mt + 4 * kq) = Ac[mt]; *(LAS f32x4*)(t0a + 96 + ebase + 16 * mt + 4 * kq) = Bc[mt]; }
            }
        } else {
            const int SS = S >> 1;
            f32x4 cin[3], cin1[3];
            const int pw = wave == 0 ? 7 : wave - 1, need = wave == 0 ? SS : SS + 1, par = (wave == 0 ? SS + 1 : SS) & 1;
            asm volatile("s_waitcnt lgkmcnt(0)" ::: "memory");
            if (need > 0) {
                while (*(volatile LAS int*)(flg + pw) < need) __builtin_amdgcn_s_sleep(0);
                asm volatile("" ::: "memory");
#pragma unroll
                for (int mt = 0; mt < 3; ++mt) cin[mt] = *(const LAS f32x4*)(agg + par * 768 + pw * 96 + ebase + 16 * mt + 4 * kq);
            } else {
#pragma unroll
                for (int mt = 0; mt < 3; ++mt) cin[mt] = (f32x4){0.f, 0.f, 0.f, 0.f};
            }
#pragma unroll
            for (int mt = 0; mt < 3; ++mt) { const f32x4 a0 = *(const LAS f32x4*)(t0a + ebase + 16 * mt + 4 * kq), b0 = *(const LAS f32x4*)(t0a + 96 + ebase + 16 * mt + 4 * kq); cin1[mt] = a0 * cin[mt] + b0; }
            if (tk == 15) {
#pragma unroll
                for (int mt = 0; mt < 3; ++mt) *(LAS f32x4*)(agg + (SS & 1) * 768 + wave * 96 + ebase + 16 * mt + 4 * kq) = Ac[mt] * cin1[mt] + Bc[mt];
            }
            asm volatile("s_waitcnt lgkmcnt(0)" ::: "memory");
            if (lane == 0) *(volatile LAS int*)(flg + wave) = SS + 1;
            {
                const int row0 = rg_row(S, b, p_t0, colmajor), row1 = rg_row(S, b, p, colmajor);
#pragma unroll
                for (int mt = 0; mt < 3; ++mt) { const int eb = ebase + 16 * mt + 4 * kq;
                    const f32x4 h0 = Bc0[mt] + Ac0[mt] * cin[mt], h1 = Bc[mt] + Ac[mt] * cin1[mt];
                    u32x2 w0; w0.x = pk2(h0.x, h0.y); w0.y = pk2(h0.z, h0.w);
                    u32x2 w1; w1.x = pk2(h1.x, h1.y); w1.y = pk2(h1.z, h1.w);
                    *(u32x2*)(HO + (size_t)row0 * DRNN + hh * 88 + eb) = w0;
                    *(u32x2*)(HO + (size_t)row1 * DRNN + hh * 88 + eb) = w1; }
            }
        }
    }
    __syncthreads();
}
__device__ __forceinline__ void phase_rg_combine(KA a, size_t gt, size_t GT) {
    const bf16_t* Z = (const bf16_t*)(a->ws + WS_Z); bf16_t* MIX = (bf16_t*)(a->ws + WS_MIX); const bf16_t* HB = (const bf16_t*)(a->ws + WS_HB);
    const size_t total = (size_t)MT * 176;
    for (size_t idx0 = gt; idx0 < total; idx0 += 4 * GT) {
        u32x4 g[4], hf[4], hb[4]; size_t off[4]; bool ok[4];
#pragma unroll
        for (int u = 0; u < 4; ++u) { const size_t idx = idx0 + u * GT; ok[u] = idx < total; const size_t ic = ok[u] ? idx : gt; const size_t row = ic / 176; const int v = (int)(ic % 176);
            off[u] = row * DRNN + 8 * v; g[u] = *(const u32x4*)(Z + row * NOIN + 8 * v); hf[u] = *(const u32x4*)(MIX + off[u]); hb[u] = *(const u32x4*)(HB + off[u]); }
#pragma unroll
        for (int u = 0; u < 4; ++u) { u32x4 o;
#pragma unroll
            for (int j = 0; j < 4; ++j) { const float s0 = bflo(hf[u][j]) + bflo(hb[u][j]), s1 = bfhi(hf[u][j]) + bfhi(hb[u][j]); o[j] = pk2(bflo(g[u][j]) * s0, bfhi(g[u][j]) * s1); }
            if (ok[u]) *(u32x4*)(MIX + off[u]) = o; }
    }
}

__global__ void __launch_bounds__(NTHR, 2) mk_fwd(Args a_unused) {
    KA a = (KA)__builtin_amdgcn_kernarg_segment_ptr();
    extern __shared__ __attribute__((aligned(16))) unsigned char lds_raw[];
    LAS unsigned char* lds = (LAS unsigned char*)lds_raw;
    const int G = gridDim.x, bid = blockIdx.x;
    volatile LAS unsigned* bst = (volatile LAS unsigned*)(lds + LDS_BYTES - 64);
    if (threadIdx.x < 2) bst[threadIdx.x] = 0u;
    __syncthreads();
    XcdBarrier bar = xcd_barrier_post((unsigned*)(a->ws + WS_BAR), bst);
#define GRID_SYNC() do { if (USE_XCD_BAR) xcd_barrier(bar); else cg::this_grid().sync(); } while (0)
    for (int ph = a->ph_lo; ph < a->ph_hi; ++ph) {
        if (ph >= 1 && ph <= 32 && ((ph - 1) & 7) == 3 && !(((ph - 1) >> 3) & 1)) continue;
        int nrep = 1;
#if PROBE_REP == 1
        if (ph >= 1 && ph <= 32 && ((ph - 1) & 7) == 2 && !(((ph - 1) >> 3) & 1)) nrep = 2;
#elif PROBE_REP == 2
        if (ph >= 1 && ph <= 32 && ((ph - 1) & 7) == 2 && (((ph - 1) >> 3) & 1)) nrep = 2;
#elif PROBE_REP == 3
        if (ph == 0) nrep = 2;
#elif PROBE_REP == 4
        if (ph >= 1 && ph <= 32 && (((ph - 1) & 7) == 0 || ((ph - 1) & 7) == 5)) nrep = 2;
#elif PROBE_REP == 6
        if (ph >= 1 && ph <= 32 && ((ph - 1) & 7) == 6) nrep = 2;
#elif PROBE_REP == 7
        if (ph >= 1 && ph <= 32 && ((ph - 1) & 7) == 1) nrep = 2;
#endif
        for (int rep = 0; rep < nrep; ++rep) {
        if (rep) GRID_SYNC();
        const int tid = mk_opaque_tid(), lane = tid & 63, wave = __builtin_amdgcn_readfirstlane(tid >> 6);
        const int gw = bid * NWAVES + wave, NGW = G * NWAVES;
        const size_t gt = (size_t)bid * NTHR + tid, GT = (size_t)G * NTHR;
        asm volatile("" : "+s"(a));
        unsigned char* ws = a->ws;
        if (ph == 0) phase0(a, lds, tid, lane, wave, bid, G);
        else if (ph == 33) phase_final(a, lane, gw, NGW);
        else {
            const int l = (ph - 1) >> 3, k = (ph - 1) & 7, i = l >> 1; const bool odd = l & 1;
            const float* modl = (const float*)(ws + WS_MOD) + (size_t)l * 5 * NMOD;
            if (k == 0) { phase_norm(a, l, 0, a->in[I_GMIX] + l * D, lane, gw, NGW, l > 0 ? DFF / 256 : 0, modl - 5 * NMOD + 5 * 1024); if (!odd) { for (int tile = bid; tile < 544; tile += G) kt_tile(a, i, tile, lds, tid); } }
            else if (k == 5) phase_norm(a, l, 3, a->in[I_GFFN] + l * D, lane, gw, NGW, l < DEPTH - 1 ? (odd ? DRNN / 128 : D / 256) : 0, modl + 2 * 1024);
            else if (k == 1) {
                if (odd) {
                    pg8::Gemm g{(const bf16_t*)(ws + WS_H), (const bf16_t*)(ws + W_OIN(i)), MT, NOIN, D, D};
                    EpiStore E{(bf16_t*)(ws + WS_Z), NOIN, 11, nullptr, 0};
                    pg8::StaticOrder S; S.init(g.M, g.N, G, bid);
                    pg8::gemm_phase<EpiStore, pg8::StaticOrder, MK_ALIGN, MK_SP2>(lds, g, S, E);
                } else {
                    pg8::Gemm g{(const bf16_t*)(ws + WS_H), (const bf16_t*)(ws + W_EIN(i)), MT, NEIN, D, D};
                    EpiStore E{(bf16_t*)(ws + WS_Z) + (size_t)1536 * MT - 1536, D, 1 << 20, (bf16_t*)(ws + WS_Z), MT};
                    pg8::MergedOrder S; S.init(G, bid);
                    pg8::gemm_phase<EpiStore, pg8::MergedOrder, MK_ALIGN, MK_SP2>(lds, g, S, E);
                }
            }
            else if (k == 2) {
                if (!odd) { for (int it = bid; it < 512 + 544; it += G) { const int nr = (PROBE_REP == 8 && it >= 512) || (PROBE_REP == 9 && it < 512) ? 2 : 1; for (int rr = 0; rr < nr; ++rr) { if (it < 512) hyena_item(a, i, it, lds, tid, lane, wave); else { const int s = it - 512, v = s & 255; sgu_item(a, i, (G == 256 && s < 512) ? ((s & ~255) + ((v & 7) * 8 + (v >> 5)) * 4 + ((v >> 3) & 3)) : s, lds, tid); } }     } }
                else { for (int it = bid; it < 256; it += G) rglru_item(a, i, (i & 1) == 1, G == 256 ? (((it & 7) * 8 + (it >> 5)) * 4 + ((it >> 3) & 3)) : it, lds); }
            }
            else if (k == 3) { if (odd) phase_rg_combine(a, gt, GT); }
            else if (k == 4 || k == 7) {
                const bf16_t* Ap; const bf16_t* Bp; int Kf;
                if (k == 7) { Ap = (const bf16_t*)(ws + WS_Z); Bp = (const bf16_t*)(ws + W_FFNOUT(l)); Kf = DFF; }
                else if (odd) { Ap = (const bf16_t*)(ws + WS_MIX); Bp = (const bf16_t*)(ws + W_OOUT(i)); Kf = DRNN; }
                else { Ap = (const bf16_t*)(ws + WS_MIX); Bp = (const bf16_t*)(ws + W_EOUT(i)); Kf = D; }
                const float* modp = modl + (k == 7 ? 5 : 2) * 1024;
                {
                    pg8::Gemm g{Ap, Bp, ML, D, Kf, Kf};
                    EpiRes E{modp, (bf16_t*)(ws + WS_XS16), (l == 0 && k == 4) ? a->in[I_X] : nullptr, 0, nullptr};
                    pg8::StaticOrder S; S.init(ML, D, G, bid);
                    pg8::gemm_phase<EpiRes, pg8::StaticOrder, true, MK_SP2>(lds, g, S, E);
                }
                if (l < DEPTH - 1) {
                    const int ksl = (Kf % 256 == 0) ? 256 : 128, nks = Kf / ksl;
                    pg8::Gemm g{Ap, Bp, MT, D, ksl, Kf};
                    EpiRes E{modp, (bf16_t*)(ws + WS_XS16), nullptr, 1, (float*)(ws + (k == 7 ? WS_MIX : WS_HB))};
                    pg8::SplitOrder S; S.init(ML / 256, MC / 256, D / 256, nks, G, bid);
                    pg8::gemm_phase<EpiRes, pg8::SplitOrder, true, MK_SP2>(lds, g, S, E);
                }
            }
            else if (k == 6) {
                pg8::Gemm g{(const bf16_t*)(ws + WS_H), (const bf16_t*)(ws + W_FFNIN(l)), MT, NFFN, D, D};
                EpiFFN E{(bf16_t*)(ws + WS_Z)};
                pg8::StaticOrder S; S.init(g.M, g.N, G, bid);
                pg8::gemm_phase<EpiFFN, pg8::StaticOrder, MK_ALIGN, MK_SP2>(lds, g, S, E);
            }
        }
        }
#if PROBE_REP == 5
        GRID_SYNC();
#endif
        if (ph + 1 < a->ph_hi) { if (a->ph_hi > 1000) cg::this_grid().sync(); else GRID_SYNC(); }
    }
}

extern "C" void kernel_launch(void* const* d_in, const int* in_sizes, int n_in, void* d_out, int out_size, void* d_ws, size_t ws_size, hipStream_t stream) {
    static int grid = 0;
    if (grid == 0) {
        if (n_in != N_IN || out_size != ML * D || ws_size < WS_END) { fprintf(stderr, "kernel_launch: unexpected shapes (n_in %d out %d ws %zu)\n", n_in, out_size, ws_size); grid = -1; return; }
        int dev = 0, cus = 0, per_cu = 0;
        if (hipGetDevice(&dev) != hipSuccess || hipDeviceGetAttribute(&cus, hipDeviceAttributeMultiprocessorCount, dev) != hipSuccess) { grid = -1; return; }
        if (hipFuncSetAttribute((const void*)mk_fwd, hipFuncAttributeMaxDynamicSharedMemorySize, LDS_BYTES) != hipSuccess) { fprintf(stderr, "kernel_launch: hipFuncSetAttribute failed\n"); grid = -1; return; }
        if (hipOccupancyMaxActiveBlocksPerMultiprocessor(&per_cu, (const void*)mk_fwd, NTHR, LDS_BYTES) != hipSuccess || per_cu < 1) { fprintf(stderr, "kernel_launch: occupancy query says %d\n", per_cu); per_cu = 1; }
        (void)hipGetLastError();
        grid = cus;
    }
    if (grid < 0) return;
    Args a{};
    for (int i = 0; i < N_IN; ++i) a.in[i] = (const float*)d_in[i];
    a.out = (float*)d_out; a.ws = (unsigned char*)d_ws;
#if MK_MULTI
    for (int ph = 0; ph < 34; ++ph) {
        if (ph >= 1 && ph <= 32) { const int l = (ph - 1) >> 3, k = (ph - 1) & 7; if (k == 3 && !(l & 1)) continue; }
        a.ph_lo = ph; a.ph_hi = ph + 1;
        hipLaunchKernelGGL(mk_fwd, dim3(grid), dim3(NTHR), LDS_BYTES, stream, a);
    }
#else
    a.ph_lo = 0; a.ph_hi = 34;
    if (hipMemsetAsync((char*)d_ws + WS_BAR, 0, 16384, stream) != hipSuccess) { fprintf(stderr, "kernel_launch: memset failed\n"); return; }
    void* args[] = {&a};
    hipError_t e = hipLaunchCooperativeKernel((const void*)mk_fwd, dim3(grid), dim3(NTHR), args, LDS_BYTES, stream);
    if (e != hipSuccess) fprintf(stderr, "cooperative launch failed: %s (grid %d)\n", hipGetErrorString(e), grid);
#endif
}
```
